# Optimizing an MI355X kernel written in HIP

```python
import jax, jax.numpy as jnp
from jax import lax
import numpy as np

D_MODEL = 1024
BATCH = 2
SEQ = 16384
DEPTH = 2

N_HEADS = 8
N_KV_HEADS = 2
HEAD_DIM = 64
ATTN_WIDTH = N_HEADS * HEAD_DIM
KV_WIDTH = N_KV_HEADS * HEAD_DIM
WINDOW = 128
BLOCK = 128
N_BUCKETS = 32
MAX_DISTANCE = 128
N_FOURIER_GROUPS = 4
FOURIER_GROUP_DIM = 128
FOURIER_WIDTH = N_FOURIER_GROUPS * FOURIER_GROUP_DIM
N_BRANCHES = 2
IN_WIDTH = ATTN_WIDTH + 2 * KV_WIDTH + FOURIER_WIDTH + N_BRANCHES * D_MODEL
N_EXPERTS = 16
CAPACITY_FACTOR = 2
D_FF = 2816
EPS = 1e-6
NEG_INF = -1e30

kernel_name = "hybrid_swa_fnet_ec_moe_encoder"


def rms_norm(x, g):
    xf = x.astype(jnp.float32)
    y = xf * lax.rsqrt(jnp.mean(xf * xf, axis=-1, keepdims=True) + EPS)
    return (y * g.astype(jnp.float32)).astype(x.dtype)


def t5_bucket(rel):
    half = N_BUCKETS // 2
    max_exact = half // 2
    ret = (rel > 0).astype(jnp.int32) * half
    n = jnp.abs(rel)
    nf = jnp.maximum(n, 1).astype(jnp.float32)
    large = max_exact + (jnp.log(nf / max_exact) / np.float32(np.log(MAX_DISTANCE / max_exact))
                         * (half - max_exact)).astype(jnp.int32)
    large = jnp.minimum(large, half - 1)
    return ret + jnp.where(n < max_exact, n, large)


def window_attention(q, k, v, sink, rel_bias):
    b, s, _ = q.shape
    nb = s // BLOCK
    g = N_HEADS // N_KV_HEADS
    qb = q.reshape(b, nb, BLOCK, N_KV_HEADS, g, HEAD_DIM)

    def windows(t):
        t = t.reshape(b, s, N_KV_HEADS, HEAD_DIM)
        t = jnp.pad(t, ((0, 0), (BLOCK, BLOCK), (0, 0), (0, 0)))
        t = t.reshape(b, nb + 2, BLOCK, N_KV_HEADS, HEAD_DIM)
        return jnp.concatenate([t[:, :-2], t[:, 1:-1], t[:, 2:]], axis=2)

    kw, vw = windows(k), windows(v)
    q_loc = jnp.arange(BLOCK)
    k_loc = jnp.arange(3 * BLOCK) - BLOCK
    rel = k_loc[None, :] - q_loc[:, None]
    bias = rel_bias[t5_bucket(rel)].astype(jnp.float32)
    bias = bias.transpose(2, 0, 1).reshape(N_KV_HEADS, g, BLOCK, 3 * BLOCK)
    k_abs = jnp.arange(nb)[:, None] * BLOCK + k_loc[None, :]
    valid = (jnp.abs(rel) <= WINDOW)[None] & ((k_abs >= 0) & (k_abs < s))[:, None, :]

    scores = jnp.einsum('bnqkgd,bnskd->bnkgqs', qb, kw,
                        preferred_element_type=jnp.float32) * (HEAD_DIM ** -0.5) + bias
    scores = jnp.where(valid[None, :, None, None], scores, NEG_INF)
    sink_l = sink.astype(jnp.float32).reshape(N_KV_HEADS, g)[:, :, None]
    m = jnp.maximum(scores.max(axis=-1), sink_l)
    p = jnp.exp(scores - m[..., None])
    denom = p.sum(axis=-1, keepdims=True) + jnp.exp(sink_l - m)[..., None]
    probs = (p / denom).astype(v.dtype)
    out = jnp.einsum('bnkgqs,bnskd->bnqkgd', probs, vw)
    return out.reshape(b, s, ATTN_WIDTH)


def fourier_mix(f):
    b, s, _ = f.shape
    fg = f.reshape(b, s, N_FOURIER_GROUPS, FOURIER_GROUP_DIM).astype(jnp.float32)
    y = jnp.fft.fft2(fg, axes=(1, 3), norm="ortho").real
    return y.reshape(b, s, FOURIER_WIDTH).astype(f.dtype)


def expert_choice_ffn(h, w_router, w_gate, w_up, w_down):
    b, s, d = h.shape
    cap = CAPACITY_FACTOR * s // N_EXPERTS
    logits = jnp.einsum('bsd,de->bse', h, w_router, preferred_element_type=jnp.float32)
    affinity = jax.nn.softmax(logits, axis=-1)
    gates, idx = lax.top_k(affinity.transpose(0, 2, 1), cap)
    xs = jax.vmap(lambda t, i: t[i])(h, idx)
    hg = jnp.einsum('becd,edf->becf', xs, w_gate)
    hu = jnp.einsum('becd,edf->becf', xs, w_up)
    y = jnp.einsum('becf,efd->becd', jax.nn.silu(hg) * hu, w_down) * gates[..., None].astype(h.dtype)
    return jax.vmap(lambda i, val: jnp.zeros((s, d), h.dtype).at[i.reshape(-1)].add(val.reshape(-1, d)))(idx, y)


def setup_inputs(seed: int = 0) -> dict:
    key = jax.random.key(seed)
    ks = jax.random.split(key, 14)
    f32 = jnp.float32
    nrm = lambda k, shape, fan_in: jax.random.normal(k, shape, f32) * (fan_in ** -0.5)
    return {
        "x": jax.random.normal(ks[0], (BATCH, SEQ, D_MODEL), f32),
        "rel_bias": jax.random.normal(ks[1], (N_BUCKETS, N_HEADS), f32) * 0.1,
        "g_mix": 1.0 + 0.02 * jax.random.normal(ks[2], (DEPTH, D_MODEL), f32),
        "w_in": nrm(ks[3], (DEPTH, D_MODEL, IN_WIDTH), D_MODEL),
        "attn_sink": jax.random.normal(ks[4], (DEPTH, N_HEADS), f32) * 0.5,
        "w_attn_proj": nrm(ks[5], (DEPTH, ATTN_WIDTH, D_MODEL), ATTN_WIDTH),
        "w_fourier_proj": nrm(ks[6], (DEPTH, FOURIER_WIDTH, D_MODEL), FOURIER_WIDTH),
        "w_out": nrm(ks[7], (DEPTH, D_MODEL, D_MODEL), D_MODEL),
        "g_ffn": 1.0 + 0.02 * jax.random.normal(ks[8], (DEPTH, D_MODEL), f32),
        "w_router": nrm(ks[9], (DEPTH, D_MODEL, N_EXPERTS), D_MODEL),
        "w_exp_gate": nrm(ks[10], (DEPTH, N_EXPERTS, D_MODEL, D_FF), D_MODEL),
        "w_exp_up": nrm(ks[11], (DEPTH, N_EXPERTS, D_MODEL, D_FF), D_MODEL),
        "w_exp_down": nrm(ks[12], (DEPTH, N_EXPERTS, D_FF, D_MODEL), D_FF),
        "g_final": 1.0 + 0.02 * jax.random.normal(ks[13], (D_MODEL,), f32),
    }


def reference(x, rel_bias, g_mix, w_in, attn_sink, w_attn_proj, w_fourier_proj, w_out,
              g_ffn, w_router, w_exp_gate, w_exp_up, w_exp_down, g_final):
    splits = np.cumsum([ATTN_WIDTH, KV_WIDTH, KV_WIDTH, FOURIER_WIDTH, D_MODEL]).tolist()
    for l in range(DEPTH):
        h = rms_norm(x, g_mix[l])
        z = jnp.einsum('bsd,de->bse', h, w_in[l])
        q, k, v, f, gate_a, gate_b = jnp.split(z, splits, axis=-1)
        a = jnp.einsum('bse,ed->bsd', window_attention(q, k, v, attn_sink[l], rel_bias), w_attn_proj[l])
        fo = jnp.einsum('bse,ed->bsd', fourier_mix(f), w_fourier_proj[l])
        merged = jax.nn.sigmoid(gate_a) * a + jax.nn.sigmoid(gate_b) * fo
        x = x + jnp.einsum('bsd,de->bse', merged, w_out[l])
        h2 = rms_norm(x, g_ffn[l])
        x = x + expert_choice_ffn(h2, w_router[l], w_exp_gate[l], w_exp_up[l], w_exp_down[l])
    return rms_norm(x, g_final)
```

```cpp
#include <hip/hip_runtime.h>
#include <cstdio>
#include <cstdint>

#define LAS __attribute__((address_space(3)))
#define GAS __attribute__((address_space(1)))
typedef unsigned short bf16_t;
typedef short bf16x8 __attribute__((ext_vector_type(8)));
typedef float f32x4 __attribute__((ext_vector_type(4)));
typedef float f32x16 __attribute__((ext_vector_type(16)));
typedef unsigned u32x4 __attribute__((ext_vector_type(4)));
typedef unsigned u32x2 __attribute__((ext_vector_type(2)));
typedef GAS unsigned gu32;

#ifndef MK_N_LAUNCHES
#define MK_N_LAUNCHES 1
#endif
#ifndef PH_MASK
#define PH_MASK 0xffff
#endif
#define PH_ON(k) ((PH_MASK >> (k)) & 1)

constexpr int D = 1024, BATCH = 2, SEQ = 16384, T = BATCH * SEQ, DEPTH = 2;
constexpr int NH = 8, HD = 64, AW = 512, KVW = 128, FW = 512, INW = 3328;
constexpr int NE = 16, CAP = 2048, DFF = 2816, NSLOT = BATCH * NE * CAP;
constexpr float EPS = 1e-6f, LOG2E = 1.4426950408889634f;
constexpr int AHW = 1536;
constexpr int NWAVES = 8, NTHR = 512;

constexpr size_t MiB = 1u << 20, KiB = 1024;
constexpr size_t WS_CTL = 0, CTL_ZERO_BYTES = 1 * MiB;
constexpr size_t WS_F1 = 1 * MiB, WS_G2 = WS_F1 + 64 * KiB, WS_TWC = WS_G2 + 128 * KiB, WS_TWS = WS_TWC + 64 * KiB, WS_WRT = WS_TWS + 64 * KiB,
                 WS_SELTOK = WS_WRT + 128 * KiB, WS_SELGATE = WS_SELTOK + 256 * KiB;
static_assert(WS_SELGATE + 256 * KiB <= 2 * MiB, "misc map");
constexpr size_t WS_AFF = 2 * MiB, WS_SLOT = 4 * MiB;
constexpr size_t WS_W = 8 * MiB, W_LAYER = 276 * MiB;
constexpr size_t WO_INM = 0, WO_F = 6 * MiB, WO_MG = 7 * MiB, WO_OUT = 10 * MiB, WO_GU = 12 * MiB, WO_D = 188 * MiB;
constexpr size_t WS_H = 560 * MiB, WS_Y = 624 * MiB, WS_MIX = 752 * MiB, WS_ACT = 752 * MiB;
constexpr size_t MX_Q = 0, MX_K = 32 * MiB, MX_VT = 40 * MiB, MX_FT = 48 * MiB, MX_GR = 80 * MiB, MX_GB = 144 * MiB, MX_AH = 208 * MiB, MX_QP = 304 * MiB, MX_MG = 368 * MiB;
constexpr size_t WS_END = 1184 * MiB;
static_assert(WS_W + 2 * W_LAYER <= WS_H && WS_MIX + MX_MG + 64 * MiB <= WS_END && WS_ACT + (size_t)NSLOT * DFF * 2 <= WS_END, "ws map");

constexpr int CW_BAR = 4096;

constexpr int RING_BYTES = 131072, MISC_OFF = RING_BYTES + 320, LDS_BYTES = 147456;

__device__ __forceinline__ unsigned f2bf(float f) { unsigned u = __builtin_bit_cast(unsigned, f); return (u + 0x7fffu + ((u >> 16) & 1u)) >> 16; }
__device__ __forceinline__ unsigned pk2(float lo, float hi) { return f2bf(lo) | (f2bf(hi) << 16); }
__device__ __forceinline__ unsigned cvt_pk_bf16(float lo, float hi) { unsigned r; asm volatile("v_cvt_pk_bf16_f32 %0, %1, %2" : "=v"(r) : "v"(lo), "v"(hi)); return r; }
__device__ __forceinline__ u32x4 pack8(const f32x4 a, const f32x4 b) { u32x4 w; w.x = cvt_pk_bf16(a[0], a[1]); w.y = cvt_pk_bf16(a[2], a[3]); w.z = cvt_pk_bf16(b[0], b[1]); w.w = cvt_pk_bf16(b[2], b[3]); return w; }
__device__ __forceinline__ float bflo(unsigned w) { return __builtin_bit_cast(float, w << 16); }
__device__ __forceinline__ float bfhi(unsigned w) { return __builtin_bit_cast(float, w & 0xffff0000u); }
__device__ __forceinline__ void unpack8(const u32x4 w, f32x4& a, f32x4& b) { a[0] = bflo(w.x); a[1] = bfhi(w.x); a[2] = bflo(w.y); a[3] = bfhi(w.y); b[0] = bflo(w.z); b[1] = bfhi(w.z); b[2] = bflo(w.w); b[3] = bfhi(w.w); }
__device__ __forceinline__ float fexp2(float x) { return __builtin_amdgcn_exp2f(x); }
__device__ __forceinline__ float frcp(float x) { return __builtin_amdgcn_rcpf(x); }
__device__ __forceinline__ float wave_sum(float v) {
#pragma unroll
    for (int o = 1; o < 64; o <<= 1) v += __shfl_xor(v, o);
    return v;
}
__device__ __forceinline__ int wave_sum_i(int v) {
#pragma unroll
    for (int o = 1; o < 64; o <<= 1) v += __shfl_xor(v, o);
    return v;
}
#define LDS_WAIT() asm volatile("s_waitcnt lgkmcnt(0)" ::: "memory")
#define VM_WAIT() asm volatile("s_waitcnt vmcnt(0)" ::: "memory")

#define XB_TMO      128
#define XB_XCNT(j)  (256  + 64 * (j))
#define XB_XSUB(j)  (1280 + 64 * (j))
#define XB_XGEN(j)  (2304 + 64 * (j))
#define XB_TOP      3328
#define XB_TOPGEN   3392
#define XCD_BAR_WORDS 3456
#define XB_SPIN_CAP (1u << 22)
__device__ __forceinline__ unsigned xb_ld(unsigned* p)              { return __hip_atomic_load(p, __ATOMIC_RELAXED, __HIP_MEMORY_SCOPE_AGENT); }
__device__ __forceinline__ unsigned xb_add(unsigned* p, unsigned v) { return __hip_atomic_fetch_add(p, v, __ATOMIC_RELAXED, __HIP_MEMORY_SCOPE_AGENT); }
__device__ __forceinline__ unsigned xb_xcc_id() { return (unsigned)__builtin_amdgcn_s_getreg((3 << 11) | 20) & 0xFu; }
#define XB_SPIN(cond, bar) do { unsigned _sp = 0; while (cond) { __builtin_amdgcn_s_sleep(1); \
    if ((++_sp & 255u) == 0u) { if (xb_ld(&(bar)[XB_TMO])) break; if (_sp > XB_SPIN_CAP) { atomicAdd(&(bar)[XB_TMO], 1u); break; } } } } while (0)
struct XcdBarrier { unsigned* bar; unsigned x; volatile LAS unsigned* st; };
__device__ __forceinline__ XcdBarrier xcd_barrier_post(unsigned* bar, volatile LAS unsigned* st) {
    XcdBarrier b; b.bar = bar; b.x = xb_xcc_id(); b.st = st;
    if (threadIdx.x == 0) (void)xb_add(&bar[XB_XCNT(b.x)], 1u);
    return b;
}
__device__ __forceinline__ void xcd_barrier_complete(unsigned* bar, unsigned x, unsigned& nloc, unsigned& nx) {
    const unsigned G = gridDim.x * gridDim.y * gridDim.z;
    unsigned sum, cnt, mine, sp = 0u;
    for (;;) {
        sum = 0u; cnt = 0u; mine = 0u;
#pragma unroll
        for (unsigned j = 0; j < 16; ++j) { const unsigned c = xb_ld(&bar[XB_XCNT(j)]); sum += c; cnt += (c > 0u) ? 1u : 0u; mine = (j == x) ? c : mine; }
        if (sum == G) break;
        __builtin_amdgcn_s_sleep(1);
        if ((++sp & 255u) == 0u) { if (xb_ld(&bar[XB_TMO])) break; if (sp > XB_SPIN_CAP) { atomicAdd(&bar[XB_TMO], 1u); break; } }
    }
    nloc = mine > 0u ? mine : 1u; nx = cnt > 0u ? cnt : 1u;
}
__device__ __forceinline__ void xcd_barrier(const XcdBarrier& b) {
    asm volatile("s_waitcnt vmcnt(0)" ::: "memory");
    __syncthreads();
    if (threadIdx.x == 0) {
        unsigned* bar = b.bar;
        __builtin_amdgcn_s_waitcnt(0);
        unsigned nloc = b.st[0], nx = b.st[1];
        if (nloc == 0u) { xcd_barrier_complete(bar, b.x, nloc, nx); b.st[0] = nloc; b.st[1] = nx; }
        const unsigned old = xb_add(&bar[XB_XSUB(b.x)], 1u);
        const unsigned gen = old / nloc;
        if (old + 1u == (gen + 1u) * nloc) {
            __builtin_amdgcn_fence(__ATOMIC_RELEASE, "agent");
            asm volatile("s_waitcnt vmcnt(0)" ::: "memory");
            const unsigned og = xb_add(&bar[XB_TOP], 1u);
            const unsigned tg = og / nx;
            if (og + 1u == (tg + 1u) * nx) xb_add(&bar[XB_TOPGEN], 1u);
            else XB_SPIN(xb_ld(&bar[XB_TOPGEN]) == tg, bar);
            __builtin_amdgcn_fence(__ATOMIC_ACQUIRE, "agent");
            xb_add(&bar[XB_XGEN(b.x)], 1u);
            asm volatile("s_waitcnt vmcnt(0)" ::: "memory");
        } else {
            XB_SPIN(xb_ld(&bar[XB_XGEN(b.x)]) == gen, bar);
            __builtin_amdgcn_fence(__ATOMIC_ACQUIRE, "agent");
            asm volatile("s_waitcnt vmcnt(0)" ::: "memory");
        }
    }
    __syncthreads();
}

namespace gm {
constexpr int BM = 256, BK = 64, HALF = 128, HTB = HALF * BK * 2, NXCD = 8, WGM = 8;
__host__ __device__ __forceinline__ int lds_byte(int r, int c) { const int st = (r >> 4) * 2 + (c >> 5), rr = r & 15, cc = c & 31, ob = rr * 64 + cc * 2; return st * 1024 + (ob ^ (((ob >> 9) & 1) << 5)); }
__host__ __device__ __forceinline__ void stage_rc(int b, int& R, int& C) { const int st = b / 1024, sb = b % 1024, swz = sb ^ (((sb >> 9) & 1) << 5); R = (st >> 1) * 16 + swz / 64; C = (st & 1) * 32 + (swz % 64) / 2; }
__host__ __device__ __forceinline__ int perm32(int rho) { const int n = rho >> 4, i = rho & 15; return 8 * (i >> 2) + 4 * n + (i & 3); }
struct Unit { int pm, pn; };
struct StaticOrder {
    int nM, nN, nwg, G, c;
    __device__ __forceinline__ void init(int nM_, int nN_, int G_, int c_) { nM = nM_; nN = nN_; nwg = nM * nN; G = G_; c = c_; }
    __device__ __forceinline__ bool next(int i, Unit& u) const {
        const long L = (long)i * G + c; if (L >= nwg) return false;
        int wgid = (int)L; { const int q = nwg / NXCD, r = nwg % NXCD, xcd = wgid % NXCD, off = wgid / NXCD; wgid = (xcd < r ? xcd * (q + 1) : r * (q + 1) + (xcd - r) * q) + off; }
        const int nig = WGM * nN, gid = wgid / nig, fm = gid * WGM, gsz = (nM - fm) < WGM ? (nM - fm) : WGM;
        u.pm = fm + ((wgid % nig) % gsz); u.pn = (wgid % nig) / gsz; return true;
    }
};
typedef f32x4 Acc[2][2][4][2];

template <class P>
__device__ __forceinline__ void gemm_phase(LAS unsigned char* lds, const P& p, int G, int cid, int tid) {
    constexpr bool GA = P::GA, GB = P::GB;
    const int wid = __builtin_amdgcn_readfirstlane(tid >> 6), lane = tid & 63, wr = wid >> 2, wc = wid & 3, fr = lane & 15, fq = lane >> 4;
    constexpr int K = P::K, nt = K / BK;
    static_assert(nt >= 2 && (nt % 2) == 0, "K must be a multiple of 128");
    unsigned vA[2], vB[2];
#pragma unroll
    for (int i = 0; i < 2; ++i) { int R, C; stage_rc(tid * 16 + i * 8192, R, C); const int Rb = (R & ~31) + perm32(R & 31); vA[i] = (unsigned)(R * P::ldA + C) * 2u; vB[i] = (unsigned)(Rb * P::ldB + C) * 2u; }
    constexpr size_t hsA = (size_t)HALF * P::ldA * 2, hsB = (size_t)HALF * P::ldB * 2;
    const unsigned ldsw = (unsigned)wid * 1024u;
    const int aoff = lds_byte(wr * 64 + fr, fq * 8), boff = lds_byte(wc * 32 + fr, fq * 8);
    unsigned gA[2][2], gB[2][2]; int preA[2][2];
#define G_GATHER_A(U, USEPRE) do { int _tz = threadIdx.x; asm volatile("" : "+v"(_tz)); _Pragma("unroll") for (int _i = 0; _i < 2; ++_i) { int _R, _C; stage_rc(_tz * 16 + _i * 8192, _R, _C); \
        _Pragma("unroll") for (int _h = 0; _h < 2; ++_h) { const int _row = (USEPRE) ? preA[_h][_i] : p.rowA(U, _h * HALF + _R); gA[_h][_i] = (unsigned)(_row * P::ldA + _C) * 2u; } } } while (0)
#define G_GATHER_B(U) do { int _tz = threadIdx.x; asm volatile("" : "+v"(_tz)); _Pragma("unroll") for (int _i = 0; _i < 2; ++_i) { int _R, _C; stage_rc(_tz * 16 + _i * 8192, _R, _C); const int _Rb = (_R & ~31) + perm32(_R & 31); \
        _Pragma("unroll") for (int _h = 0; _h < 2; ++_h) gB[_h][_i] = (unsigned)(p.rowB(U, _h * HALF + _Rb) * P::ldB + _C) * 2u; } } while (0)
#define G_PREF_A(U) do { int _tz = threadIdx.x; asm volatile("" : "+v"(_tz)); _Pragma("unroll") for (int _i = 0; _i < 2; ++_i) { int _R, _C; stage_rc(_tz * 16 + _i * 8192, _R, _C); \
        _Pragma("unroll") for (int _h = 0; _h < 2; ++_h) preA[_h][_i] = p.rowA(U, _h * HALF + _R); } } while (0)
#define G_SA(b, h) (((b) * 2 + (h)) * HTB)
#define G_SB(b, h) ((4 + (b) * 2 + (h)) * HTB)
#define G_GLDS(src, dstoff) __builtin_amdgcn_global_load_lds((const unsigned*)(src), (LAS unsigned*)(lds + (dstoff)), 16, 0, 0)
#define G_STAGE_A(bufoff, h, kt) do { const char* _b = GA ? (cA + (size_t)(kt) * 128) : (cA + (size_t)(h) * hsA + (size_t)(kt) * 128); \
        G_GLDS(_b + (GA ? gA[h][0] : vA[0]), (bufoff) + ldsw); G_GLDS(_b + (GA ? gA[h][1] : vA[1]), (bufoff) + ldsw + 8192); } while (0)
#define G_STAGE_B(bufoff, h, kt) do { const char* _b = GB ? (cB + (size_t)(kt) * 128) : (cB + (size_t)(h) * hsB + (size_t)(kt) * 128); \
        G_GLDS(_b + (GB ? gB[h][0] : vB[0]), (bufoff) + ldsw); G_GLDS(_b + (GB ? gB[h][1] : vB[1]), (bufoff) + ldsw + 8192); } while (0)
#define G_LDA(dst, b, h) do { _Pragma("unroll") for (int m = 0; m < 4; ++m) _Pragma("unroll") for (int k = 0; k < 2; ++k) dst[m][k] = *(const LAS bf16x8*)(lds + G_SA(b, h) + aoff + m * 2048 + k * 1024); } while (0)
#define G_LDB(dst, b, h) do { _Pragma("unroll") for (int n = 0; n < 2; ++n) _Pragma("unroll") for (int k = 0; k < 2; ++k) dst[n][k] = *(const LAS bf16x8*)(lds + G_SB(b, h) + boff + n * 2048 + k * 1024); } while (0)
#define G_MMA(ai, bj, At, Bt) do { __builtin_amdgcn_s_setprio(1); _Pragma("unroll") for (int m = 0; m < 4; ++m) _Pragma("unroll") for (int n = 0; n < 2; ++n) _Pragma("unroll") for (int k = 0; k < 2; ++k) \
        acc[ai][bj][m][n] = __builtin_amdgcn_mfma_f32_16x16x32_bf16(Bt[n][k], At[m][k], acc[ai][bj][m][n], 0, 0, 0); __builtin_amdgcn_s_setprio(0); } while (0)
#define G_WAIT_V(n) asm volatile("s_waitcnt vmcnt(" #n ")" ::: "memory")
#define G_WAIT_L(n) asm volatile("s_waitcnt lgkmcnt(" #n ")" ::: "memory")
#define G_BAR __builtin_amdgcn_s_barrier()
#define G_SCHED __builtin_amdgcn_sched_barrier(0)
    StaticOrder S; S.init(P::nM, P::nN, G, cid);
    Unit cur, nxt; int ui = 0;
    if (!S.next(0, cur)) return;
    Acc acc;
#pragma unroll
    for (int a = 0; a < 2; ++a)
#pragma unroll
        for (int b = 0; b < 2; ++b)
#pragma unroll
            for (int m = 0; m < 4; ++m)
#pragma unroll
                for (int n = 0; n < 2; ++n) acc[a][b][m][n] = (f32x4){0.f, 0.f, 0.f, 0.f};
    bf16x8 At[4][2], B0[2][2], B1[2][2];
    const char* cA = p.tileA(cur); const char* cB = p.tileB(cur);
    if constexpr (GA) { G_GATHER_A(cur, false); }
    if constexpr (GB) { G_GATHER_B(cur); }
    if constexpr (GA) { VM_WAIT(); }
    G_STAGE_B(G_SB(0, 0), 0, 0); G_STAGE_B(G_SB(0, 1), 1, 0); G_STAGE_A(G_SA(0, 0), 0, 0); G_STAGE_A(G_SA(0, 1), 1, 0);
    if (wr == 1) G_BAR;
    G_WAIT_V(2); G_BAR;
    G_STAGE_B(G_SB(1, 0), 0, 1); G_STAGE_A(G_SA(1, 0), 0, 1); G_STAGE_B(G_SB(1, 1), 1, 1);
    G_WAIT_V(6); G_BAR;
    for (;;) {
        const bool has_next = S.next(ui + 1, nxt);
        { size_t _z = 0; asm volatile("" : "+s"(_z)); cA += _z; cB += _z; }
        const char* nA = has_next ? p.tileA(nxt) : cA; const char* nB = has_next ? p.tileB(nxt) : cB;
        if constexpr (GA && P::PREFA) { if (has_next) G_PREF_A(nxt); }
        int ntr = nt; asm volatile("" : "+s"(ntr));
#pragma nounroll
        for (int t = 0; t < ntr; t += 2) {
            const bool last = (t == ntr - 2);
            if constexpr (P::HOOK_KT > 0) { if (t == P::HOOK_KT) { int tz = threadIdx.x; asm volatile("" : "+v"(tz)); const int wid2 = tz >> 6, lane2 = tz & 63; p.hook(acc, cur, wid2 >> 2, wid2 & 3, lane2 & 15, lane2 >> 4); } }
            G_LDB(B0, 0, 0); G_LDB(B1, 0, 1); G_SCHED; G_LDA(At, 0, 0); G_STAGE_A(G_SA(1, 1), 1, t + 1);
            G_WAIT_V(8); G_WAIT_L(0); G_BAR; G_MMA(0, 0, At, B0); G_MMA(0, 1, At, B1); G_BAR; G_SCHED;
            int kb = t + 2;
            if (last) {
                kb = 0;
                if (has_next) {
                    cA = nA; cB = nB;
                    if constexpr (GA) { G_GATHER_A(nxt, P::PREFA); }
                    if constexpr (GB) { G_GATHER_B(nxt); }
                }
            }
            G_LDA(At, 0, 1); G_STAGE_B(G_SB(0, 0), 0, kb); G_STAGE_B(G_SB(0, 1), 1, kb); G_STAGE_A(G_SA(0, 0), 0, kb);
            G_WAIT_V(8); G_WAIT_L(0); G_BAR; G_MMA(1, 0, At, B0); G_MMA(1, 1, At, B1); G_BAR; G_SCHED;
            G_LDB(B0, 1, 0); G_LDB(B1, 1, 1); G_SCHED; G_LDA(At, 1, 0); G_STAGE_A(G_SA(0, 1), 1, kb);
            G_WAIT_V(8); G_WAIT_L(0); G_BAR; G_MMA(0, 0, At, B0); G_MMA(0, 1, At, B1); G_BAR; G_SCHED;
            G_LDA(At, 1, 1); G_STAGE_B(G_SB(1, 0), 0, kb + 1); G_STAGE_B(G_SB(1, 1), 1, kb + 1); G_STAGE_A(G_SA(1, 0), 0, kb + 1);
            G_WAIT_V(8); G_WAIT_L(0); G_BAR; G_MMA(1, 0, At, B0); G_MMA(1, 1, At, B1); G_BAR; G_SCHED;
        }
        if (wr == 0) G_BAR;
        { int tz = threadIdx.x; asm volatile("" : "+v"(tz));
          const int wid2 = tz >> 6, lane2 = tz & 63; p.epi(acc, cur, wid2 >> 2, wid2 & 3, lane2 & 15, lane2 >> 4); }
        if (!has_next) break;
#pragma unroll
        for (int a = 0; a < 2; ++a)
#pragma unroll
            for (int b = 0; b < 2; ++b)
#pragma unroll
                for (int m = 0; m < 4; ++m)
#pragma unroll
                    for (int n = 0; n < 2; ++n) acc[a][b][m][n] = (f32x4){0.f, 0.f, 0.f, 0.f};
        cur = nxt; ++ui;
        if (wr == 1) G_BAR;
    }
    G_WAIT_V(0);
    G_BAR;
#undef G_GATHER_A
#undef G_GATHER_B
#undef G_PREF_A
#undef G_SA
#undef G_SB
#undef G_GLDS
#undef G_STAGE_A
#undef G_STAGE_B
#undef G_LDA
#undef G_LDB
#undef G_MMA
#undef G_WAIT_V
#undef G_WAIT_L
#undef G_BAR
#undef G_SCHED
}
}
using gm::Unit; using gm::Acc;

struct PInM {
    static constexpr bool GA = false, GB = false, PREFA = false; static constexpr int HOOK_KT = 0, K = D, ldA = D, ldB = D, nM = T / 256, nN = 11;
    const bf16_t* A; const bf16_t* B; bf16_t *Q, *Kb, *VT, *GR, *GBt;
    __device__ __forceinline__ const char* tileA(const Unit& u) const { return (const char*)A + (size_t)u.pm * 256 * ldA * 2; }
    __device__ __forceinline__ const char* tileB(const Unit& u) const { return (const char*)B + (size_t)u.pn * 256 * ldB * 2; }
    __device__ __forceinline__ int rowA(const Unit&, int) const { return 0; }
    __device__ __forceinline__ int rowB(const Unit&, int) const { return 0; }
    __device__ __forceinline__ void hook(Acc&, const Unit&, int, int, int, int) const {}
    __device__ __forceinline__ void epi(const Acc& acc, const Unit& u, int wr, int wc, int fr, int fq) const {
        const int row0 = u.pm * 256 + wr * 64 + fr, cw = wc * 32 + 8 * fq;
        if (u.pn < 2) {
#pragma unroll
            for (int ai = 0; ai < 2; ++ai)
#pragma unroll
                for (int m = 0; m < 4; ++m) { bf16_t* rp = Q + (size_t)(row0 + ai * 128 + m * 16) * AW + u.pn * 256 + cw;
#pragma unroll
                    for (int bj = 0; bj < 2; ++bj) *(u32x4*)(rp + bj * 128) = pack8(acc[ai][bj][m][0], acc[ai][bj][m][1]); }
        } else if (u.pn == 2) {
#pragma unroll
            for (int ai = 0; ai < 2; ++ai)
#pragma unroll
                for (int m = 0; m < 4; ++m) { const int row = row0 + ai * 128 + m * 16;
                    *(u32x4*)(Kb + (size_t)row * KVW + cw) = pack8(acc[ai][0][m][0], acc[ai][0][m][1]);
                    const int b = row >> 14, s = row & (SEQ - 1);
#pragma unroll
                    for (int n = 0; n < 2; ++n)
#pragma unroll
                        for (int j = 0; j < 4; ++j) VT[(size_t)(b * KVW + cw + 4 * n + j) * SEQ + s] = (bf16_t)f2bf(acc[ai][1][m][n][j]); }
        } else {
            const int cc = (u.pn - 3) * 128 + cw;
#pragma unroll
            for (int ai = 0; ai < 2; ++ai)
#pragma unroll
                for (int m = 0; m < 4; ++m) { const size_t o = (size_t)(row0 + ai * 128 + m * 16) * D + cc; f32x4 r[2], s[2];
#pragma unroll
                    for (int n = 0; n < 2; ++n)
#pragma unroll
                        for (int j = 0; j < 4; ++j) { const float ea = fexp2(fminf(-acc[ai][0][m][n][j] * LOG2E, 80.f)), eb = fexp2(fminf(-acc[ai][1][m][n][j] * LOG2E, 80.f));
                            s[n][j] = frcp(1.f + eb); r[n][j] = (1.f + eb) * frcp(1.f + ea); }
                    *(u32x4*)(GR + o) = pack8(r[0], r[1]); *(u32x4*)(GBt + o) = pack8(s[0], s[1]); }
        }
    }
};
struct PInF {
    static constexpr bool GA = false, GB = true, PREFA = false; static constexpr int HOOK_KT = 0, K = D, ldA = D, ldB = D, nM = 2, nN = T / 256;
    const bf16_t* A; const bf16_t* B; bf16_t* FT;
    __device__ __forceinline__ const char* tileA(const Unit& u) const { return (const char*)A + (size_t)u.pm * 256 * ldA * 2; }
    __device__ __forceinline__ const char* tileB(const Unit&) const { return (const char*)B; }
    __device__ __forceinline__ int rowA(const Unit&, int) const { return 0; }
    __device__ __forceinline__ int rowB(const Unit& u, int c) const { const int np = u.pn * 256 + c, b = np >> 14, n2 = np & (SEQ - 1); return b * SEQ + (n2 & 127) * 128 + (n2 >> 7); }
    __device__ __forceinline__ void hook(Acc&, const Unit&, int, int, int, int) const {}
    __device__ __forceinline__ void epi(const Acc& acc, const Unit& u, int wr, int wc, int fr, int fq) const {
        const int ch0 = u.pm * 256 + wr * 64 + fr, b = u.pn >> 6, nc = (u.pn & 63) * 256 + wc * 32 + 8 * fq;
#pragma unroll
        for (int ai = 0; ai < 2; ++ai)
#pragma unroll
            for (int m = 0; m < 4; ++m) { bf16_t* rp = FT + (size_t)(b * FW + ch0 + ai * 128 + m * 16) * SEQ + nc;
#pragma unroll
                for (int bj = 0; bj < 2; ++bj) *(u32x4*)(rp + bj * 128) = pack8(acc[ai][bj][m][0], acc[ai][bj][m][1]); }
    }
};
struct PF1 {
    static constexpr bool GA = false, GB = false, PREFA = false; static constexpr int HOOK_KT = 0, K = 128, ldA = 128, ldB = 128, nM = 1, nN = BATCH * FW * 128 / 256;
    const bf16_t* A; const bf16_t* B; bf16_t* QP; const float* twc; const float* tws;
    __device__ __forceinline__ const char* tileA(const Unit&) const { return (const char*)A; }
    __device__ __forceinline__ const char* tileB(const Unit& u) const { return (const char*)B + (size_t)u.pn * 256 * ldB * 2; }
    __device__ __forceinline__ int rowA(const Unit&, int) const { return 0; }
    __device__ __forceinline__ int rowB(const Unit&, int) const { return 0; }
    __device__ __forceinline__ void hook(Acc&, const Unit&, int, int, int, int) const {}
    __device__ __forceinline__ void epi(const Acc& acc, const Unit& u, int wr, int wc, int fr, int fq) const {
        const int cw = wc * 32 + 8 * fq;
#pragma unroll
        for (int m = 0; m < 4; ++m) { const int klo = wr * 64 + m * 16 + fr;
            f32x4 c[2], s[2];
#pragma unroll
            for (int n = 0; n < 2; ++n) { c[n] = *(const f32x4*)(twc + klo * 128 + cw + 4 * n); s[n] = *(const f32x4*)(tws + klo * 128 + cw + 4 * n); }
#pragma unroll
            for (int bj = 0; bj < 2; ++bj) { f32x4 qr[2], qi[2];
#pragma unroll
                for (int n = 0; n < 2; ++n) { const f32x4 pr = acc[0][bj][m][n], pi = acc[1][bj][m][n]; qr[n] = pr * c[n] + pi * s[n]; qi[n] = pi * c[n] - pr * s[n]; }
                bf16_t* rp = QP + ((size_t)((u.pn * 2 + bj) * 128 + klo) * 2) * 128 + cw;
                *(u32x4*)(rp) = pack8(qr[0], qr[1]); *(u32x4*)(rp + 128) = pack8(qi[0], qi[1]); }
            asm volatile("" ::: "memory"); }
    }
};
struct PF2 {
    static constexpr bool GA = false, GB = true, PREFA = false; static constexpr int HOOK_KT = 0, K = 256, ldA = 256, ldB = 256, nM = 1, nN = 512;
    const bf16_t* A; const bf16_t* B; bf16_t* AH;
    __device__ __forceinline__ const char* tileA(const Unit&) const { return (const char*)A; }
    __device__ __forceinline__ const char* tileB(const Unit&) const { return (const char*)B; }
    __device__ __forceinline__ int rowA(const Unit&, int) const { return 0; }
    __device__ __forceinline__ int rowB(const Unit& u, int c) const { const int b = u.pn >> 8, chq = (u.pn >> 6) & 3, klo = (u.pn & 63) * 2 + (c >> 7), ch = chq * 128 + (c & 127); return (b * FW + ch) * 128 + klo; }
    __device__ __forceinline__ void hook(Acc&, const Unit&, int, int, int, int) const {}
    __device__ __forceinline__ void epi(const Acc& acc, const Unit& u, int wr, int wc, int fr, int fq) const {
        const int b = u.pn >> 8, chq = (u.pn >> 6) & 3, klo0 = (u.pn & 63) * 2, ch = chq * 128 + wc * 32 + 8 * fq;
#pragma unroll
        for (int ai = 0; ai < 2; ++ai)
#pragma unroll
            for (int m = 0; m < 4; ++m) { const int khi = wr * 64 + m * 16 + fr;
#pragma unroll
                for (int bj = 0; bj < 2; ++bj) { const int tok = b * SEQ + 128 * khi + klo0 + bj;
                    *(u32x4*)(AH + (size_t)tok * AHW + 512 + ai * 512 + ch) = pack8(acc[ai][bj][m][0], acc[ai][bj][m][1]); } }
    }
};
struct PMg {
    static constexpr bool GA = false, GB = false, PREFA = false; static constexpr int HOOK_KT = 8, K = AHW, ldA = AHW, ldB = AHW, nM = T / 256, nN = 4;
    const bf16_t* A; const bf16_t* B; const bf16_t* GR; const bf16_t* GBt; bf16_t* MG;
    __device__ __forceinline__ const char* tileA(const Unit& u) const { return (const char*)A + (size_t)u.pm * 256 * ldA * 2; }
    __device__ __forceinline__ const char* tileB(const Unit& u) const { return (const char*)B + (size_t)u.pn * 256 * ldB * 2; }
    __device__ __forceinline__ int rowA(const Unit&, int) const { return 0; }
    __device__ __forceinline__ int rowB(const Unit&, int) const { return 0; }
    __device__ __forceinline__ void hook(Acc& acc, const Unit& u, int wr, int wc, int fr, int fq) const {
        const size_t o0 = (size_t)(u.pm * 256 + wr * 64 + fr) * D + u.pn * 256 + wc * 32 + 8 * fq;
#pragma unroll
        for (int ai = 0; ai < 2; ++ai)
#pragma unroll
            for (int m = 0; m < 4; ++m)
#pragma unroll
                for (int bj = 0; bj < 2; ++bj) { const u32x4 w = *(const u32x4*)(GR + o0 + (size_t)(ai * 128 + m * 16) * D + bj * 128); f32x4 r0, r1; unpack8(w, r0, r1);
                    acc[ai][bj][m][0] *= r0; acc[ai][bj][m][1] *= r1; asm volatile("" ::: "memory"); }
    }
    __device__ __forceinline__ void epi(const Acc& acc, const Unit& u, int wr, int wc, int fr, int fq) const {
        const size_t o0 = (size_t)(u.pm * 256 + wr * 64 + fr) * D + u.pn * 256 + wc * 32 + 8 * fq;
#pragma unroll
        for (int ai = 0; ai < 2; ++ai)
#pragma unroll
            for (int m = 0; m < 4; ++m)
#pragma unroll
                for (int bj = 0; bj < 2; ++bj) { const size_t o = o0 + (size_t)(ai * 128 + m * 16) * D + bj * 128; const u32x4 w = *(const u32x4*)(GBt + o); f32x4 s0, s1; unpack8(w, s0, s1);
                    *(u32x4*)(MG + o) = pack8(acc[ai][bj][m][0] * s0, acc[ai][bj][m][1] * s1); asm volatile("" ::: "memory"); }
    }
};
struct POut {
    static constexpr bool GA = false, GB = false, PREFA = false; static constexpr int HOOK_KT = 0, K = D, ldA = D, ldB = D, nM = T / 256, nN = 4;
    const bf16_t* A; const bf16_t* B; const float* xin; float* xout;
    __device__ __forceinline__ const char* tileA(const Unit& u) const { return (const char*)A + (size_t)u.pm * 256 * ldA * 2; }
    __device__ __forceinline__ const char* tileB(const Unit& u) const { return (const char*)B + (size_t)u.pn * 256 * ldB * 2; }
    __device__ __forceinline__ int rowA(const Unit&, int) const { return 0; }
    __device__ __forceinline__ int rowB(const Unit&, int) const { return 0; }
    __device__ __forceinline__ void hook(Acc&, const Unit&, int, int, int, int) const {}
    __device__ __forceinline__ void epi(const Acc& acc, const Unit& u, int wr, int wc, int fr, int fq) const {
        const size_t o0 = (size_t)(u.pm * 256 + wr * 64 + fr) * D + u.pn * 256 + wc * 32 + 8 * fq;
#pragma unroll
        for (int ai = 0; ai < 2; ++ai)
#pragma unroll
            for (int m = 0; m < 4; ++m) {
#pragma unroll
                for (int bj = 0; bj < 2; ++bj) { const size_t o = o0 + (size_t)(ai * 128 + m * 16) * D + bj * 128;
                    const f32x4 x0 = *(const f32x4*)(xin + o), x1 = *(const f32x4*)(xin + o + 4);
                    *(f32x4*)(xout + o) = x0 + acc[ai][bj][m][0]; *(f32x4*)(xout + o + 4) = x1 + acc[ai][bj][m][1]; }
                asm volatile("" ::: "memory"); }
    }
};
struct PUp {
    static constexpr bool GA = true, GB = false, PREFA = true; static constexpr int HOOK_KT = 0, K = D, ldA = D, ldB = D, nM = NSLOT / 256, nN = 22;
    const bf16_t* A; const bf16_t* B; const int* seltok; bf16_t* ACT;
    __device__ __forceinline__ const char* tileA(const Unit&) const { return (const char*)A; }
    __device__ __forceinline__ const char* tileB(const Unit& u) const { return (const char*)B + (size_t)(u.pm >> 4) * (2 * DFF) * ldB * 2 + (size_t)u.pn * 256 * ldB * 2; }
    __device__ __forceinline__ int rowA(const Unit& u, int r) const { return seltok[u.pm * 256 + r]; }
    __device__ __forceinline__ int rowB(const Unit&, int) const { return 0; }
    __device__ __forceinline__ void hook(Acc&, const Unit&, int, int, int, int) const {}
    __device__ __forceinline__ void epi(const Acc& acc, const Unit& u, int wr, int wc, int fr, int fq) const {
        const int row0 = u.pm * 256 + wr * 64 + fr, cc = u.pn * 128 + wc * 32 + 8 * fq;
#pragma unroll
        for (int ai = 0; ai < 2; ++ai)
#pragma unroll
            for (int m = 0; m < 4; ++m) { f32x4 a[2];
#pragma unroll
                for (int n = 0; n < 2; ++n)
#pragma unroll
                    for (int j = 0; j < 4; ++j) { const float g = acc[ai][0][m][n][j], up = acc[ai][1][m][n][j]; a[n][j] = g * up * frcp(1.f + fexp2(fminf(-g * LOG2E, 80.f))); }
                *(u32x4*)(ACT + (size_t)(row0 + ai * 128 + m * 16) * DFF + cc) = pack8(a[0], a[1]); }
    }
};
struct PDn {
    static constexpr bool GA = false, GB = false, PREFA = false; static constexpr int HOOK_KT = 0, K = DFF, ldA = DFF, ldB = DFF, nM = NSLOT / 256, nN = 4;
    const bf16_t* A; const bf16_t* B; const float* selgate; bf16_t* Y;
    __device__ __forceinline__ const char* tileA(const Unit& u) const { return (const char*)A + (size_t)u.pm * 256 * ldA * 2; }
    __device__ __forceinline__ const char* tileB(const Unit& u) const { return (const char*)B + (size_t)(u.pm >> 4) * D * ldB * 2 + (size_t)u.pn * 256 * ldB * 2; }
    __device__ __forceinline__ int rowA(const Unit&, int) const { return 0; }
    __device__ __forceinline__ int rowB(const Unit&, int) const { return 0; }
    __device__ __forceinline__ void hook(Acc&, const Unit&, int, int, int, int) const {}
    __device__ __forceinline__ void epi(const Acc& acc, const Unit& u, int wr, int wc, int fr, int fq) const {
        const int row0 = u.pm * 256 + wr * 64 + fr, cc = u.pn * 256 + wc * 32 + 8 * fq;
#pragma unroll
        for (int ai = 0; ai < 2; ++ai)
#pragma unroll
            for (int m = 0; m < 4; ++m) { const int row = row0 + ai * 128 + m * 16; const float g = selgate[row];
#pragma unroll
                for (int bj = 0; bj < 2; ++bj) *(u32x4*)(Y + (size_t)row * D + cc + bj * 128) = pack8(acc[ai][bj][m][0] * g, acc[ai][bj][m][1] * g); }
    }
};

struct Args { const float* in[14]; float* out; unsigned char* ws; int ph_lo, ph_hi, li, pad; };
struct Frame {
    LAS unsigned char* lds; volatile LAS unsigned* MISC; unsigned* ctl; unsigned char* ws;
    int tid, lane, wave, vcu, G, bid;
};
__device__ __forceinline__ bf16_t* wsb(const Frame& F, size_t off) { return (bf16_t*)(F.ws + off); }

__device__ __forceinline__ void tr_item(const float* src, int ldn, const float* rs, float cs, bf16_t* dst, int ldd, LAS float* scr, int lane) {
#pragma unroll 8
    for (int i = 0; i < 32; ++i) { const int kk = 2 * i + (lane >> 5); const float sc = rs ? rs[kk] * cs : cs; scr[kk * 33 + (lane & 31)] = src[(size_t)kk * ldn + (lane & 31)] * sc; }
    LDS_WAIT(); asm volatile("" ::: "memory");
    const int c = lane & 7;
#pragma unroll
    for (int j = 0; j < 4; ++j) { const int n = (lane >> 3) + 8 * j; const LAS float* s = scr + (8 * c) * 33 + n;
        u32x4 o; o.x = pk2(s[0 * 33], s[1 * 33]); o.y = pk2(s[2 * 33], s[3 * 33]); o.z = pk2(s[4 * 33], s[5 * 33]); o.w = pk2(s[6 * 33], s[7 * 33]);
        *(u32x4*)(dst + (size_t)n * ldd + 8 * c) = o; }
    LDS_WAIT(); asm volatile("" ::: "memory");
}
__device__ __forceinline__ void p0_prologue(const Frame& F, const Args& a) {
    LAS float* scr = (LAS float*)(F.lds + F.wave * 16384);
    LAS float* cs128 = (LAS float*)(F.lds + 7 * 16384 + 12288);
    if (F.tid < 128) { cs128[F.tid] = cospif((float)F.tid / 64.f); cs128[128 + F.tid] = sinpif((float)F.tid / 64.f); }
    __syncthreads();
    const int gw = F.vcu * NWAVES + F.wave, NGW = F.G * NWAVES, lane = F.lane;
    const float* w_in = a.in[3]; const float* g_mix = a.in[2]; const float* w_ap = a.in[5]; const float* w_fp = a.in[6]; const float* w_out = a.in[7];
    const float* g_ffn = a.in[8]; const float* w_router = a.in[9]; const float* w_eg = a.in[10]; const float* w_eu = a.in[11]; const float* w_ed = a.in[12];
    constexpr int I_INM = 88 * 16, I_F = 16 * 16, I_AP = 32 * 8, I_OUT = 32 * 16, I_GU = NE * 176 * 16, I_DN = NE * 32 * 44;
    constexpr int I_LAYER = I_INM + I_F + I_AP + I_OUT + I_GU + I_DN;
    for (int it = gw; it < DEPTH * I_LAYER; it += NGW) {
        const int l = it / I_LAYER; int r = it - l * I_LAYER;
        unsigned char* wl = F.ws + WS_W + (size_t)l * W_LAYER;
        if (r < I_INM) { const int rb = r >> 4, kb = r & 15, dr = rb * 32; int sc; float cs = 1.f;
            if (dr < 768) { sc = dr; if (dr < 512) cs = 0.125f * LOG2E; }
            else { const int d2 = dr - 768, jj = d2 >> 8, w = d2 & 255; sc = (w < 128) ? (1280 + 128 * jj + w) : (2304 + 128 * jj + (w - 128)); }
            tr_item(w_in + (size_t)l * D * INW + (size_t)(kb * 64) * INW + sc, INW, g_mix + l * D + kb * 64, cs, (bf16_t*)(wl + WO_INM) + (size_t)dr * D + kb * 64, D, scr, lane); continue; }
        r -= I_INM;
        if (r < I_F) { const int rb = r >> 4, kb = r & 15, dr = rb * 32;
            tr_item(w_in + (size_t)l * D * INW + (size_t)(kb * 64) * INW + 768 + dr, INW, g_mix + l * D + kb * 64, 1.f, (bf16_t*)(wl + WO_F) + (size_t)dr * D + kb * 64, D, scr, lane); continue; }
        r -= I_F;
        if (r < I_AP) { const int rb = r >> 3, kb = r & 7, dr = rb * 32;
            tr_item(w_ap + (size_t)l * AW * D + (size_t)(kb * 64) * D + dr, D, nullptr, 1.f, (bf16_t*)(wl + WO_MG) + (size_t)dr * AHW + kb * 64, AHW, scr, lane); continue; }
        r -= I_AP;
        if (r < I_OUT) { const int rb = r >> 4, kb = r & 15, dr = rb * 32;
            tr_item(w_out + (size_t)l * D * D + (size_t)(kb * 64) * D + dr, D, nullptr, 1.f, (bf16_t*)(wl + WO_OUT) + (size_t)dr * D + kb * 64, D, scr, lane); continue; }
        r -= I_OUT;
        if (r < I_GU) { const int e = r / (176 * 16), r2 = r - e * (176 * 16), rb = r2 >> 4, kb = r2 & 15, dr = rb * 32, jj = dr >> 8, w = dr & 255;
            const float* src = (w < 128 ? w_eg : w_eu) + ((size_t)(l * NE + e) * D + kb * 64) * DFF + 128 * jj + (w & 127);
            tr_item(src, DFF, g_ffn + l * D + kb * 64, 1.f, (bf16_t*)(wl + WO_GU) + ((size_t)e * (2 * DFF) + dr) * D + kb * 64, D, scr, lane); continue; }
        r -= I_GU;
        { const int e = r / (32 * 44), r2 = r - e * (32 * 44), rb = r2 / 44, kb = r2 - rb * 44, dr = rb * 32;
            tr_item(w_ed + ((size_t)(l * NE + e) * DFF + kb * 64) * D + dr, D, nullptr, 1.f, (bf16_t*)(wl + WO_D) + ((size_t)e * D + dr) * DFF + kb * 64, DFF, scr, lane); }
    }
    for (int it = gw; it < DEPTH * 4 * 16 * 16; it += NGW) {
        const int l = it >> 10, g = (it >> 8) & 3, n2b = (it >> 4) & 15, nb = it & 15, n = nb * 64 + lane, n20 = n2b * 8;
        const float* wp = w_fp + (size_t)l * FW * D + (size_t)(g * 128) * D + n;
        float ac[8], as[8];
#pragma unroll
        for (int i = 0; i < 8; ++i) { ac[i] = 0.f; as[i] = 0.f; }
        for (int k2 = 0; k2 < 128; ++k2) { const float w = wp[(size_t)k2 * D];
#pragma unroll
            for (int i = 0; i < 8; ++i) { const int idx = (k2 * (n20 + i)) & 127; ac[i] += cs128[idx] * w; as[i] += cs128[128 + idx] * w; } }
        const float isq = 0.08838834764831845f;
        bf16_t* dst = (bf16_t*)(F.ws + WS_W + (size_t)l * W_LAYER + WO_MG) + (size_t)n * AHW + 512 + g * 128 + n20;
        u32x4 oc, os; oc.x = pk2(ac[0] * isq, ac[1] * isq); oc.y = pk2(ac[2] * isq, ac[3] * isq); oc.z = pk2(ac[4] * isq, ac[5] * isq); oc.w = pk2(ac[6] * isq, ac[7] * isq);
        os.x = pk2(as[0] * isq, as[1] * isq); os.y = pk2(as[2] * isq, as[3] * isq); os.z = pk2(as[4] * isq, as[5] * isq); os.w = pk2(as[6] * isq, as[7] * isq);
        *(u32x4*)dst = oc; *(u32x4*)(dst + 512) = os;
    }
    const int gt = (F.vcu * NTHR + F.tid), NGT = F.G * NTHR; const float isq = 0.08838834764831845f;
    bf16_t* F1 = wsb(F, WS_F1); bf16_t* G2 = wsb(F, WS_G2); float* twc = (float*)(F.ws + WS_TWC); float* tws = (float*)(F.ws + WS_TWS); float* wrt = (float*)(F.ws + WS_WRT);
    for (int i = gt; i < 256 * 128; i += NGT) { const int m = i >> 7, k = i & 127, idx = ((m & 127) * k) & 127; const float v = (m < 128) ? cospif((float)idx / 64.f) : -sinpif((float)idx / 64.f); F1[i] = (bf16_t)f2bf(v * isq); }
    for (int i = gt; i < 256 * 256; i += NGT) { const int m = i >> 8, k = i & 255, ro = m >> 7, ri = k >> 7, idx = ((m & 127) * (k & 127)) & 127; const float c = cospif((float)idx / 64.f), s = sinpif((float)idx / 64.f);
        const float v = (ro == ri) ? c : (ro == 0 ? s : -s); G2[i] = (bf16_t)f2bf(v * isq); }
    for (int i = gt; i < 128 * 128; i += NGT) { const int klo = i >> 7, nlo = i & 127; const float ang = (float)(klo * nlo) / 8192.f; twc[i] = cospif(ang); tws[i] = sinpif(ang); }
    for (int i = gt; i < DEPTH * NE * D; i += NGT) { const int l = i / (NE * D), e = (i / D) % NE, d = i % D; wrt[i] = g_ffn[l * D + d] * w_router[((size_t)l * D + d) * NE + e]; }
}

template <bool COMBINE, bool STORE_X, bool FINAL>
__device__ __forceinline__ void rp1(const Frame& F, const float* xsrc, float* xdst, bf16_t* h, const float* gfin) {
    const int gw = F.vcu * NWAVES + F.wave, NGW = F.G * NWAVES, lane = F.lane;
    const int* slot = (const int*)(F.ws + WS_SLOT); const bf16_t* Y = wsb(F, WS_Y);
    for (int m = gw; m < T; m += NGW) {
        f32x4 v[4];
#pragma unroll
        for (int j = 0; j < 4; ++j) v[j] = *(const f32x4*)(xsrc + (size_t)m * D + 4 * lane + 256 * j);
        if constexpr (COMBINE) {
            for (int e = 0; e < NE; ++e) { const int s = __builtin_amdgcn_readfirstlane(slot[m * NE + e]);
                if (s >= 0) {
#pragma unroll
                    for (int j = 0; j < 4; ++j) { const u32x2 w = *(const u32x2*)(Y + (size_t)s * D + 4 * lane + 256 * j); v[j][0] += bflo(w.x); v[j][1] += bfhi(w.x); v[j][2] += bflo(w.y); v[j][3] += bfhi(w.y); } } }
        }
        float ss = 0.f;
#pragma unroll
        for (int j = 0; j < 4; ++j) ss += (v[j][0] * v[j][0] + v[j][1] * v[j][1]) + (v[j][2] * v[j][2] + v[j][3] * v[j][3]);
        const float rstd = 1.0f / sqrtf(wave_sum(ss) * (1.f / D) + EPS);
        if constexpr (FINAL) {
#pragma unroll
            for (int j = 0; j < 4; ++j) { const f32x4 g = *(const f32x4*)(gfin + 4 * lane + 256 * j); *(f32x4*)(xdst + (size_t)m * D + 4 * lane + 256 * j) = v[j] * rstd * g; }
        } else {
            if constexpr (STORE_X) {
#pragma unroll
                for (int j = 0; j < 4; ++j) *(f32x4*)(xdst + (size_t)m * D + 4 * lane + 256 * j) = v[j];
            }
#pragma unroll
            for (int j = 0; j < 4; ++j) { u32x2 w; w.x = pk2(v[j][0] * rstd, v[j][1] * rstd); w.y = pk2(v[j][2] * rstd, v[j][3] * rstd); *(u32x2*)(h + (size_t)m * D + 4 * lane + 256 * j) = w; }
        }
    }
}
__device__ __forceinline__ void rp2(const Frame& F, const float* x, bf16_t* h, int layer) {
    const int gw = F.vcu * NWAVES + F.wave, NGW = F.G * NWAVES, lane = F.lane;
    LAS float* wl = (LAS float*)F.lds;
    const float* wrt = (const float*)(F.ws + WS_WRT) + (size_t)layer * NE * D;
    for (int i = F.tid; i < NE * D / 4; i += NTHR) ((LAS f32x4*)wl)[i] = ((const f32x4*)wrt)[i];
    __syncthreads();
    float* aff = (float*)(F.ws + WS_AFF); int* slot = (int*)(F.ws + WS_SLOT);
    for (int m = gw; m < T; m += NGW) {
        f32x4 v[4]; float ss = 0.f;
#pragma unroll
        for (int j = 0; j < 4; ++j) { v[j] = *(const f32x4*)(x + (size_t)m * D + 4 * lane + 256 * j); ss += (v[j][0] * v[j][0] + v[j][1] * v[j][1]) + (v[j][2] * v[j][2] + v[j][3] * v[j][3]); }
        const float rstd = 1.0f / sqrtf(wave_sum(ss) * (1.f / D) + EPS);
#pragma unroll
        for (int j = 0; j < 4; ++j) { u32x2 w; w.x = pk2(v[j][0] * rstd, v[j][1] * rstd); w.y = pk2(v[j][2] * rstd, v[j][3] * rstd); *(u32x2*)(h + (size_t)m * D + 4 * lane + 256 * j) = w; }
        float mine = -3.0e38f;
#pragma unroll 2
        for (int e = 0; e < NE; ++e) { float s = 0.f;
#pragma unroll
            for (int j = 0; j < 4; ++j) { const f32x4 w = *(const LAS f32x4*)(wl + e * D + 4 * lane + 256 * j); s += (v[j][0] * w[0] + v[j][1] * w[1]) + (v[j][2] * w[2] + v[j][3] * w[3]); }
            const float tot = wave_sum(s) * rstd; mine = (lane == e) ? tot : mine; }
        float mx = mine;
#pragma unroll
        for (int o = 1; o < 64; o <<= 1) mx = fmaxf(mx, __shfl_xor(mx, o));
        const float ex = (lane < NE) ? expf(mine - mx) : 0.f;
        const float den = wave_sum(ex);
        if (lane < NE) { const int b = m >> 14, s = m & (SEQ - 1); aff[(size_t)(b * NE + lane) * SEQ + s] = ex / den; slot[m * NE + lane] = -1; }
    }
    __syncthreads();
}
__device__ __forceinline__ void topk_phase(const Frame& F) {
    if (F.bid >= BATCH * NE) return;
    const int e = F.bid >> 1, b = F.bid & 1, tid = F.tid, lane = F.lane, wave = F.wave;
    const unsigned* a = (const unsigned*)(F.ws + WS_AFF) + (size_t)(b * NE + e) * SEQ;
    LAS int* red = (LAS int*)F.lds;
    unsigned v[32];
#pragma unroll
    for (int j = 0; j < 8; ++j) { const u32x4 w = *(const u32x4*)(a + 32 * tid + 4 * j); v[4 * j] = w.x; v[4 * j + 1] = w.y; v[4 * j + 2] = w.z; v[4 * j + 3] = w.w; }
    unsigned Tv = 0u; int it = 0;
    for (int bit = 30; bit >= 0; --bit, ++it) {
        const unsigned cand = Tv | (1u << bit); int c = 0;
#pragma unroll
        for (int j = 0; j < 32; ++j) c += (v[j] >= cand) ? 1 : 0;
        c = wave_sum_i(c);
        LAS int* slot = red + (it & 1) * 8;
        if (lane == 0) slot[wave] = c;
        __syncthreads();
        int tot = 0;
#pragma unroll
        for (int w = 0; w < 8; ++w) tot += slot[w];
        if (tot >= CAP) Tv = cand;
    }
    __syncthreads();
    int cg = 0, ce = 0;
#pragma unroll
    for (int j = 0; j < 32; ++j) { cg += (v[j] > Tv) ? 1 : 0; ce += (v[j] == Tv) ? 1 : 0; }
    int sg = cg, se = ce;
#pragma unroll
    for (int o = 1; o < 64; o <<= 1) { const int tg = __shfl_up(sg, o), te = __shfl_up(se, o); if (lane >= o) { sg += tg; se += te; } }
    LAS int* wtot = red + 16;
    if (lane == 63) { wtot[wave] = sg; wtot[8 + wave] = se; }
    __syncthreads();
    int bg = 0, be = 0, totg = 0;
#pragma unroll
    for (int w = 0; w < 8; ++w) { const int xg = wtot[w], xe = wtot[8 + w]; if (w < wave) { bg += xg; be += xe; } totg += xg; }
    int pg = bg + sg - cg, pe = be + se - ce;
    const int need = CAP - totg;
    const int slotbase = (e * BATCH + b) * CAP;
    int* seltok = (int*)(F.ws + WS_SELTOK); float* selgate = (float*)(F.ws + WS_SELGATE); int* slot = (int*)(F.ws + WS_SLOT);
#pragma unroll
    for (int j = 0; j < 32; ++j) {
        const bool isg = v[j] > Tv, ise = v[j] == Tv;
        const bool sel = isg || (ise && pe < need);
        if (sel) { const int pos = slotbase + pg + (pe < need ? pe : need); const int tok = b * SEQ + 32 * tid + j;
            seltok[pos] = tok; selgate[pos] = __builtin_bit_cast(float, v[j]); slot[tok * NE + e] = pos; }
        pg += isg ? 1 : 0; pe += ise ? 1 : 0;
    }
}

constexpr int AT_K = 0, AT_VT = 49152, AT_VPITCH = 776, AT_TAB = AT_VT + 64 * AT_VPITCH, AT_END = AT_TAB + 4 * 512 * 4;
static_assert(AT_END <= RING_BYTES && (AT_TAB % 16) == 0, "attention LDS");
__device__ __forceinline__ int crow(int r, int hi) { return (r & 3) + 8 * (r >> 2) + 4 * hi; }
__device__ __forceinline__ int t5_bucket(int rel) {
    const int n = rel < 0 ? -rel : rel; const int ret = rel > 0 ? 16 : 0;
    if (n < 8) return ret + n;
    int lg = 8 + (n >= 12) + (n >= 16) + (n >= 23) + (n >= 32) + (n >= 46) + (n >= 64) + (n >= 91);
    return ret + lg;
}
__device__ __forceinline__ void attn_phase(const Frame& F, const bf16_t* Q, const bf16_t* Kb, const bf16_t* VT, bf16_t* AH, const float* rel_bias, const float* sink) {
    LAS unsigned char* lds = F.lds; const int tid = F.tid, lane = F.lane, wave = F.wave;
    LAS float* TAB = (LAS float*)(lds + AT_TAB);
    for (int ui = F.bid; ui < BATCH * 128 * 2; ui += F.G) {
        const int kvh = ui & 1, nb = (ui >> 1) & 127, b = ui >> 8;
        const int s0 = 128 * nb - 128;
        __syncthreads();
#pragma unroll
        for (int i = 0; i < 6; ++i) { const int id = tid + 512 * i, row = id >> 3, ch = id & 7, s = s0 + row;
            u32x4 w = (u32x4){0u, 0u, 0u, 0u}; if (s >= 0 && s < SEQ) w = *(const u32x4*)(Kb + (size_t)(b * SEQ + s) * KVW + kvh * 64 + ch * 8);
            *(LAS u32x4*)(lds + AT_K + row * 128 + ((ch ^ (row & 7)) << 4)) = w; }
#pragma unroll
        for (int i = 0; i < 6; ++i) { const int id = tid + 512 * i, d = id / 48, ch = id - d * 48, s = s0 + 8 * ch;
            u32x4 w = (u32x4){0u, 0u, 0u, 0u}; if (s >= 0 && s < SEQ) w = *(const u32x4*)(VT + (size_t)(b * KVW + kvh * 64 + d) * SEQ + s);
            LAS u32x2* dp = (LAS u32x2*)(lds + AT_VT + d * AT_VPITCH + ch * 16); dp[0] = (u32x2){w.x, w.y}; dp[1] = (u32x2){w.z, w.w}; }
#pragma unroll
        for (int g = 0; g < 4; ++g) { const int rel = tid - 256; TAB[g * 512 + tid] = (rel >= -128 && rel <= 128) ? rel_bias[t5_bucket(rel) * NH + kvh * 4 + g] * LOG2E : -1.0e30f; }
        __syncthreads();
        const int g = wave >> 1, h = kvh * 4 + g, q = lane & 31, hh = lane >> 5;
        const float sk = sink[h] * LOG2E;
        for (int qb = 0; qb < 2; ++qb) {
            const int qoff = (wave & 1) * 64 + qb * 32, qloc = qoff + q; const size_t tok = (size_t)b * SEQ + 128 * nb + qloc;
            bf16x8 qf[4];
#pragma unroll
            for (int ks = 0; ks < 4; ++ks) qf[ks] = *(const bf16x8*)(Q + tok * AW + h * 64 + 16 * ks + 8 * hh);
            float mrun = sk, lrun = 1.f; f32x16 O0, O1;
#pragma unroll
            for (int r = 0; r < 16; ++r) { O0[r] = 0.f; O1[r] = 0.f; }
            int tlo = qoff >> 5, thi = tlo + 8; if (nb == 0 && tlo < 4) tlo = 4; if (nb == 127 && thi > 7) thi = 7;
            const LAS float* tb = TAB + g * 512 + 128 - qloc;
            for (int t = tlo; t <= thi; ++t) {
                f32x16 S;
#pragma unroll
                for (int r = 0; r < 16; ++r) S[r] = 0.f;
                const int krow = 32 * t + q;
#pragma unroll
                for (int ks = 0; ks < 4; ++ks) { const bf16x8 kf = *(const LAS bf16x8*)(lds + AT_K + krow * 128 + (((2 * ks + hh) ^ (krow & 7)) << 4));
                    S = __builtin_amdgcn_mfma_f32_32x32x16_bf16(kf, qf[ks], S, 0, 0, 0); }
                float tmax = -3.0e38f;
#pragma unroll
                for (int r = 0; r < 16; ++r) { S[r] += tb[32 * t + crow(r, hh)]; tmax = fmaxf(tmax, S[r]); }
                tmax = fmaxf(tmax, __shfl_xor(tmax, 32));
                const float mnew = fmaxf(mrun, tmax), alpha = fexp2(mrun - mnew); mrun = mnew;
                float ps = 0.f;
#pragma unroll
                for (int r = 0; r < 16; ++r) { S[r] = fexp2(S[r] - mnew); ps += S[r]; }
                ps += __shfl_xor(ps, 32);
                lrun = lrun * alpha + ps;
#pragma unroll
                for (int r = 0; r < 16; ++r) { O0[r] *= alpha; O1[r] *= alpha; }
                u32x4 p0, p1;
                p0.x = cvt_pk_bf16(S[0], S[1]); p0.y = cvt_pk_bf16(S[2], S[3]); p0.z = cvt_pk_bf16(S[4], S[5]); p0.w = cvt_pk_bf16(S[6], S[7]);
                p1.x = cvt_pk_bf16(S[8], S[9]); p1.y = cvt_pk_bf16(S[10], S[11]); p1.z = cvt_pk_bf16(S[12], S[13]); p1.w = cvt_pk_bf16(S[14], S[15]);
                const bf16x8 pf0 = __builtin_bit_cast(bf16x8, p0), pf1 = __builtin_bit_cast(bf16x8, p1);
#pragma unroll
                for (int s = 0; s < 2; ++s) {
                    const int kofs = (32 * t + 16 * s + 4 * hh) * 2;
                    const LAS unsigned char* v0 = lds + AT_VT + q * AT_VPITCH + kofs; const LAS unsigned char* v1 = v0 + 32 * AT_VPITCH;
                    const u32x2 a0 = *(const LAS u32x2*)(v0), a1 = *(const LAS u32x2*)(v0 + 16), c0 = *(const LAS u32x2*)(v1), c1 = *(const LAS u32x2*)(v1 + 16);
                    const bf16x8 vf0 = __builtin_bit_cast(bf16x8, (u32x4){a0.x, a0.y, a1.x, a1.y}), vf1 = __builtin_bit_cast(bf16x8, (u32x4){c0.x, c0.y, c1.x, c1.y});
                    O0 = __builtin_amdgcn_mfma_f32_32x32x16_bf16(vf0, s == 0 ? pf0 : pf1, O0, 0, 0, 0);
                    O1 = __builtin_amdgcn_mfma_f32_32x32x16_bf16(vf1, s == 0 ? pf0 : pf1, O1, 0, 0, 0);
                }
            }
            const float inv = 1.0f / lrun;
            bf16_t* op = AH + tok * AHW + h * 64 + 4 * hh;
#pragma unroll
            for (int r4 = 0; r4 < 4; ++r4) {
                u32x2 w0, w1; w0.x = cvt_pk_bf16(O0[4 * r4] * inv, O0[4 * r4 + 1] * inv); w0.y = cvt_pk_bf16(O0[4 * r4 + 2] * inv, O0[4 * r4 + 3] * inv);
                w1.x = cvt_pk_bf16(O1[4 * r4] * inv, O1[4 * r4 + 1] * inv); w1.y = cvt_pk_bf16(O1[4 * r4 + 2] * inv, O1[4 * r4 + 3] * inv);
                *(u32x2*)(op + 8 * r4) = w0; *(u32x2*)(op + 32 + 8 * r4) = w1; }
        }
    }
    __syncthreads();
}

__device__ __forceinline__ bool in_range(int k, int lo, int hi) { asm volatile("" : "+s"(lo), "+s"(hi)); return lo <= k && k < hi; }
constexpr int PH_PER_LAYER = 10, N_PHASES = 1 + DEPTH * PH_PER_LAYER + 1;
__global__ void __launch_bounds__(NTHR, 2) mk_fwd(Args args) {
    extern __shared__ __attribute__((aligned(16))) unsigned char lds_raw[];
    Frame F;
    F.lds = (LAS unsigned char*)lds_raw; F.MISC = (volatile LAS unsigned*)(F.lds + MISC_OFF);
    F.tid = threadIdx.x; F.lane = F.tid & 63; F.wave = __builtin_amdgcn_readfirstlane(F.tid >> 6);
    F.G = gridDim.x; F.bid = blockIdx.x; F.vcu = F.bid;
    F.ws = args.ws; F.ctl = (unsigned*)(args.ws + WS_CTL);
    for (int u = F.tid; u < (LDS_BYTES - RING_BYTES) / 4; u += NTHR) ((LAS unsigned*)(F.lds + RING_BYTES))[u] = 0u;
    __syncthreads();
    XcdBarrier bar; bar.bar = F.ctl + CW_BAR; bar.x = 0; bar.st = nullptr;
    if (MK_N_LAUNCHES == 1) bar = xcd_barrier_post(F.ctl + CW_BAR, F.MISC + 8);
    const int lo = args.ph_lo, hi = args.ph_hi;
#if MK_N_LAUNCHES == 1
#define IN(k) true
#else
#define IN(k) in_range((k), lo, hi)
#endif
#define PHASE_BEGIN() do { int _tz = threadIdx.x; asm volatile("" : "+v"(_tz)); F.tid = _tz; F.lane = _tz & 63; size_t _z = 0; int _g = gridDim.x, _b = blockIdx.x; asm volatile("" : "+s"(_z), "+s"(_g), "+s"(_b)); F.ws = args.ws + _z; F.G = _g; F.bid = _b; F.vcu = (_g % 8 == 0) ? (_b % 8) * (_g / 8) + _b / 8 : _b; } while (0)
#define SEAM(k) do { if (IN(k) && IN((k) + 1)) xcd_barrier(bar); } while (0)
    const float* x_in = args.in[0]; float* xo = args.out;
#define WB(off) wsb(F, (off))
    if (PH_ON(0) && IN(0)) { PHASE_BEGIN(); p0_prologue(F, args); __syncthreads(); }
    SEAM(0);
    for (int l = 0; l < DEPTH; ++l) {
        const int pb = 1 + l * PH_PER_LAYER;
        const size_t wlo = WS_W + (size_t)l * W_LAYER;
        if (PH_ON(1) && IN(pb + 0)) { PHASE_BEGIN(); if (l == 0) rp1<false, false, false>(F, x_in, nullptr, WB(WS_H), nullptr); else rp1<true, true, false>(F, xo, xo, WB(WS_H), nullptr); }
        SEAM(pb + 0);
        if (IN(pb + 1)) {
            if (PH_ON(2)) { PHASE_BEGIN(); PInM p{WB(WS_H), WB(wlo + WO_INM), WB(WS_MIX + MX_Q), WB(WS_MIX + MX_K), WB(WS_MIX + MX_VT), WB(WS_MIX + MX_GR), WB(WS_MIX + MX_GB)}; gm::gemm_phase(F.lds, p, F.G, F.bid, F.tid); }
            if (PH_ON(3)) { PHASE_BEGIN(); PInF p{WB(wlo + WO_F), WB(WS_H), WB(WS_MIX + MX_FT)}; gm::gemm_phase(F.lds, p, F.G, F.bid, F.tid); }
        }
        SEAM(pb + 1);
        if (IN(pb + 2)) {
            if (PH_ON(4)) { PHASE_BEGIN(); attn_phase(F, WB(WS_MIX + MX_Q), WB(WS_MIX + MX_K), WB(WS_MIX + MX_VT), WB(WS_MIX + MX_AH), args.in[1], args.in[4] + l * NH); }
            if (PH_ON(5)) { PHASE_BEGIN(); PF1 p{WB(WS_F1), WB(WS_MIX + MX_FT), WB(WS_MIX + MX_QP), (const float*)(F.ws + WS_TWC), (const float*)(F.ws + WS_TWS)}; gm::gemm_phase(F.lds, p, F.G, F.bid, F.tid); }
        }
        SEAM(pb + 2);
        if (PH_ON(6) && IN(pb + 3)) { PHASE_BEGIN(); PF2 p{WB(WS_G2), WB(WS_MIX + MX_QP), WB(WS_MIX + MX_AH)}; gm::gemm_phase(F.lds, p, F.G, F.bid, F.tid); }
        SEAM(pb + 3);
        if (PH_ON(7) && IN(pb + 4)) { PHASE_BEGIN(); PMg p{WB(WS_MIX + MX_AH), WB(wlo + WO_MG), WB(WS_MIX + MX_GR), WB(WS_MIX + MX_GB), WB(WS_MIX + MX_MG)}; gm::gemm_phase(F.lds, p, F.G, F.bid, F.tid); }
        SEAM(pb + 4);
        if (PH_ON(8) && IN(pb + 5)) { PHASE_BEGIN(); POut p{WB(WS_MIX + MX_MG), WB(wlo + WO_OUT), l == 0 ? x_in : (const float*)xo, xo}; gm::gemm_phase(F.lds, p, F.G, F.bid, F.tid); }
        SEAM(pb + 5);
        if (PH_ON(9) && IN(pb + 6)) { PHASE_BEGIN(); rp2(F, xo, WB(WS_H), l); }
        SEAM(pb + 6);
        if (PH_ON(10) && IN(pb + 7)) { PHASE_BEGIN(); topk_phase(F); }
        SEAM(pb + 7);
        if (PH_ON(11) && IN(pb + 8)) { PHASE_BEGIN(); PUp p{WB(WS_H), WB(wlo + WO_GU), (const int*)(F.ws + WS_SELTOK), WB(WS_ACT)}; gm::gemm_phase(F.lds, p, F.G, F.bid, F.tid); }
        SEAM(pb + 8);
        if (PH_ON(12) && IN(pb + 9)) { PHASE_BEGIN(); PDn p{WB(WS_ACT), WB(wlo + WO_D), (const float*)(F.ws + WS_SELGATE), WB(WS_Y)}; gm::gemm_phase(F.lds, p, F.G, F.bid, F.tid); }
        SEAM(pb + 9);
    }
    if (PH_ON(13) && IN(N_PHASES - 1)) { PHASE_BEGIN(); rp1<true, false, true>(F, xo, xo, nullptr, args.in[13]); }
#undef WB
#undef IN
#undef SEAM
}

extern "C" void kernel_launch(void* const* d_in, const int* in_sizes, int n_in, void* d_out, int out_size, void* d_ws, size_t ws_size, hipStream_t stream) {
    static int grid = 0;
    if (grid == 0) {
        if (n_in != 14 || out_size != T * D || ws_size < WS_END) { fprintf(stderr, "kernel_launch: unexpected shapes (n_in %d out %d ws %zu); nothing launched\n", n_in, out_size, ws_size); grid = -1; return; }
        int dev = 0, cus = 0, per_cu = 0;
        if (hipGetDevice(&dev) != hipSuccess || hipDeviceGetAttribute(&cus, hipDeviceAttributeMultiprocessorCount, dev) != hipSuccess) { grid = -1; return; }
        if (hipFuncSetAttribute((const void*)mk_fwd, hipFuncAttributeMaxDynamicSharedMemorySize, LDS_BYTES) != hipSuccess) { fprintf(stderr, "kernel_launch: hipFuncSetAttribute failed\n"); grid = -1; return; }
        if (hipOccupancyMaxActiveBlocksPerMultiprocessor(&per_cu, (const void*)mk_fwd, NTHR, LDS_BYTES) != hipSuccess || per_cu < 1) fprintf(stderr, "kernel_launch: occupancy query says %d\n", per_cu);
        (void)hipGetLastError();
        grid = cus;
    }
    if (grid < 0) return;
    (void)hipMemsetAsync((char*)d_ws + WS_CTL, 0, CTL_ZERO_BYTES, stream);
    Args a{};
    for (int i = 0; i < 14; ++i) a.in[i] = (const float*)d_in[i];
    a.out = (float*)d_out; a.ws = (unsigned char*)d_ws;
#if MK_N_LAUNCHES == 1
    a.ph_lo = 0; a.ph_hi = N_PHASES; a.li = 0;
    hipLaunchKernelGGL(mk_fwd, dim3(grid), dim3(NTHR), LDS_BYTES, stream, a);
#else
    for (int ph = 0; ph < N_PHASES; ++ph) { a.ph_lo = ph; a.ph_hi = ph + 1; a.li = ph; hipLaunchKernelGGL(mk_fwd, dim3(grid), dim3(NTHR), LDS_BYTES, stream, a); }
#endif
}
```

```cpp
#include <hip/hip_runtime.h>
#include <cstdio>
#include <cstdint>

#define LAS __attribute__((address_space(3)))
#define GAS __attribute__((address_space(1)))
typedef unsigned short bf16_t;
typedef short bf16x8 __attribute__((ext_vector_type(8)));
typedef float f32x4 __attribute__((ext_vector_type(4)));
typedef float f32x16 __attribute__((ext_vector_type(16)));
typedef unsigned u32x4 __attribute__((ext_vector_type(4)));
typedef unsigned u32x2 __attribute__((ext_vector_type(2)));
typedef GAS unsigned gu32;
typedef int v8i32 __attribute__((ext_vector_type(8)));
typedef int v4i32 __attribute__((ext_vector_type(4)));

#ifndef MK_N_LAUNCHES
#define MK_N_LAUNCHES 1
#endif
#ifndef FFN_FP8
#define FFN_FP8 1
#endif
#ifndef USE_FILLER
#define USE_FILLER 0
#endif
#ifndef PH_MASK
#define PH_MASK 0xffff
#endif
#define PH_ON(k) ((PH_MASK >> (k)) & 1)
#ifndef PH_REP
#define PH_REP 0
#endif
#ifndef PROBE_MODE
#define PROBE_MODE 0
#endif
#ifndef PROBE_K
#define PROBE_K 0
#endif
#define PROBE_AMP 4
#define REPS(k) _Pragma("nounroll") for (int _rep = 0; _rep < 1 + ((PH_REP >> (k)) & 1); ++_rep)

constexpr int D = 1024, BATCH = 2, SEQ = 16384, T = BATCH * SEQ, DEPTH = 2;
constexpr int NH = 8, HD = 64, AW = 512, KVW = 128, FW = 512, INW = 3328;
constexpr int NE = 16, CAP = 2048, DFF = 2816, NSLOT = BATCH * NE * CAP;
constexpr float EPS = 1e-6f, LOG2E = 1.4426950408889634f;
constexpr int AHW = 1536;
constexpr int NWAVES = 8, NTHR = 512;

constexpr size_t MiB = 1u << 20, KiB = 1024;
constexpr size_t WS_CTL = 0, CTL_ZERO_BYTES = 1 * MiB;
constexpr size_t WS_F1 = 1 * MiB, WS_G2 = WS_F1 + 64 * KiB, WS_TWC = WS_G2 + 128 * KiB, WS_TWS = WS_TWC + 64 * KiB, WS_WRT = WS_TWS + 64 * KiB,
                 WS_SELTOK = WS_WRT + 128 * KiB, WS_SELGATE = WS_SELTOK + 256 * KiB;
static_assert(WS_SELGATE + 256 * KiB <= 2 * MiB, "misc map");
constexpr size_t WS_AFF = 2 * MiB, WS_SLOT = 4 * MiB;
constexpr size_t WS_W = 8 * MiB, W_LAYER = 276 * MiB;
constexpr size_t WO_INM = 0, WO_F = 6 * MiB, WO_MG = 7 * MiB, WO_OUT = 10 * MiB, WO_GU = 12 * MiB, WO_D = 188 * MiB;
constexpr size_t WS_H = 560 * MiB, WS_Y = 624 * MiB, WS_MIX = 752 * MiB, WS_ACT = 752 * MiB;
constexpr size_t MX_Q = 0, MX_K = 32 * MiB, MX_VT = 40 * MiB, MX_FT = 48 * MiB, MX_GR = 80 * MiB, MX_GB = 144 * MiB, MX_AH = 208 * MiB, MX_QP = 304 * MiB, MX_MG = 368 * MiB;
constexpr size_t WS_XB = 1184 * MiB;
constexpr size_t WS_END = 1248 * MiB;
static_assert(WS_W + 2 * W_LAYER <= WS_H && WS_MIX + MX_MG + 64 * MiB <= WS_END && WS_ACT + (size_t)NSLOT * DFF * 2 <= WS_END, "ws map");

constexpr int CW_BAR = 4096;

constexpr int RING_BYTES = 131072, MISC_OFF = RING_BYTES + 320, LDS_BYTES = 147456;

__device__ __forceinline__ unsigned f2bf(float f) { unsigned u = __builtin_bit_cast(unsigned, f); return (u + 0x7fffu + ((u >> 16) & 1u)) >> 16; }
__device__ __forceinline__ unsigned pk2(float lo, float hi) { return f2bf(lo) | (f2bf(hi) << 16); }
__device__ __forceinline__ unsigned cvt_pk_bf16(float lo, float hi) { unsigned r; asm volatile("v_cvt_pk_bf16_f32 %0, %1, %2" : "=v"(r) : "v"(lo), "v"(hi)); return r; }
__device__ __forceinline__ u32x4 pack8(const f32x4 a, const f32x4 b) { u32x4 w; w.x = cvt_pk_bf16(a[0], a[1]); w.y = cvt_pk_bf16(a[2], a[3]); w.z = cvt_pk_bf16(b[0], b[1]); w.w = cvt_pk_bf16(b[2], b[3]); return w; }
__device__ __forceinline__ float bflo(unsigned w) { return __builtin_bit_cast(float, w << 16); }
__device__ __forceinline__ float bfhi(unsigned w) { return __builtin_bit_cast(float, w & 0xffff0000u); }
__device__ __forceinline__ void unpack8(const u32x4 w, f32x4& a, f32x4& b) { a[0] = bflo(w.x); a[1] = bfhi(w.x); a[2] = bflo(w.y); a[3] = bfhi(w.y); b[0] = bflo(w.z); b[1] = bfhi(w.z); b[2] = bflo(w.w); b[3] = bfhi(w.w); }
__device__ __forceinline__ float fexp2(float x) { return __builtin_amdgcn_exp2f(x); }
__device__ __forceinline__ float frcp(float x) { return __builtin_amdgcn_rcpf(x); }
template <int CTRL> __device__ __forceinline__ float dpp_mov(float v) { return __builtin_bit_cast(float, __builtin_amdgcn_mov_dpp(__builtin_bit_cast(int, v), CTRL, 0xF, 0xF, true)); }
template <int O> __device__ __forceinline__ float swz_xor(float v) {
    if constexpr (O == 1) return dpp_mov<0xB1>(v);
    else if constexpr (O == 2) return dpp_mov<0x4E>(v);
    else if constexpr (O == 4) { int t = __builtin_amdgcn_update_dpp(0, __builtin_bit_cast(int, v), 0x104, 0xF, 0x5, false); t = __builtin_amdgcn_update_dpp(t, __builtin_bit_cast(int, v), 0x114, 0xF, 0xA, false); return __builtin_bit_cast(float, t); }
    else { static_assert(O == 8, "swz_xor: O in {1,2,4,8}"); return dpp_mov<0x128>(v); }
}
__device__ __forceinline__ float x32_sum(float v) { const unsigned u = __builtin_bit_cast(unsigned, v); auto r = __builtin_amdgcn_permlane32_swap(u, u, false, false); return __builtin_bit_cast(float, (unsigned)r[0]) + __builtin_bit_cast(float, (unsigned)r[1]); }
__device__ __forceinline__ float x32_max(float v) { const unsigned u = __builtin_bit_cast(unsigned, v); auto r = __builtin_amdgcn_permlane32_swap(u, u, false, false); return fmaxf(__builtin_bit_cast(float, (unsigned)r[0]), __builtin_bit_cast(float, (unsigned)r[1])); }
__device__ __forceinline__ float x32_get(float v, bool up) { const unsigned u = __builtin_bit_cast(unsigned, v); auto r = __builtin_amdgcn_permlane32_swap(u, u, false, false); return __builtin_bit_cast(float, up ? (unsigned)r[0] : (unsigned)r[1]); }
__device__ __forceinline__ float x16_sum(float v) { const unsigned u = __builtin_bit_cast(unsigned, v); auto r = __builtin_amdgcn_permlane16_swap(u, u, false, false); return __builtin_bit_cast(float, (unsigned)r[0]) + __builtin_bit_cast(float, (unsigned)r[1]); }
__device__ __forceinline__ float x16_max(float v) { const unsigned u = __builtin_bit_cast(unsigned, v); auto r = __builtin_amdgcn_permlane16_swap(u, u, false, false); return fmaxf(__builtin_bit_cast(float, (unsigned)r[0]), __builtin_bit_cast(float, (unsigned)r[1])); }
__device__ __forceinline__ float x16_get(float v, bool odd) { const unsigned u = __builtin_bit_cast(unsigned, v); auto r = __builtin_amdgcn_permlane16_swap(u, u, false, false); return __builtin_bit_cast(float, odd ? (unsigned)r[0] : (unsigned)r[1]); }
__device__ __forceinline__ float wave_sum(float v) { v += dpp_mov<0xB1>(v); v += dpp_mov<0x4E>(v); v += dpp_mov<0x141>(v); v += dpp_mov<0x140>(v); v = x16_sum(v); return x32_sum(v); }
__device__ __forceinline__ int wave_sum_i(int v) { return (int)wave_sum((float)v); }
#define LDS_WAIT() asm volatile("s_waitcnt lgkmcnt(0)" ::: "memory")
#define VM_WAIT() asm volatile("s_waitcnt vmcnt(0)" ::: "memory")

#define XB_TMO      128
#define XB_XCNT(j)  (256  + 64 * (j))
#define XB_XSUB(j)  (1280 + 64 * (j))
#define XB_XGEN(j)  (2304 + 64 * (j))
#define XB_TOP      3328
#define XB_TOPGEN   3392
#define XCD_BAR_WORDS 3456
#define XB_SPIN_CAP (1u << 22)
__device__ __forceinline__ unsigned xb_ld(unsigned* p)              { return __hip_atomic_load(p, __ATOMIC_RELAXED, __HIP_MEMORY_SCOPE_AGENT); }
__device__ __forceinline__ unsigned xb_add(unsigned* p, unsigned v) { return __hip_atomic_fetch_add(p, v, __ATOMIC_RELAXED, __HIP_MEMORY_SCOPE_AGENT); }
__device__ __forceinline__ unsigned xb_xcc_id() { return (unsigned)__builtin_amdgcn_s_getreg((3 << 11) | 20) & 0xFu; }
#define XB_SPIN(cond, bar) do { unsigned _sp = 0; while (cond) { __builtin_amdgcn_s_sleep(1); \
    if ((++_sp & 255u) == 0u) { if (xb_ld(&(bar)[XB_TMO])) break; if (_sp > XB_SPIN_CAP) { atomicAdd(&(bar)[XB_TMO], 1u); break; } } } } while (0)
struct XcdBarrier { unsigned* bar; unsigned x; volatile LAS unsigned* st; };
__device__ __forceinline__ XcdBarrier xcd_barrier_post(unsigned* bar, volatile LAS unsigned* st) {
    XcdBarrier b; b.bar = bar; b.x = xb_xcc_id(); b.st = st;
    if (threadIdx.x == 0) (void)xb_add(&bar[XB_XCNT(b.x)], 1u);
    return b;
}
__device__ __forceinline__ void xcd_barrier_complete(unsigned* bar, unsigned x, unsigned& nloc, unsigned& nx) {
    const unsigned G = gridDim.x * gridDim.y * gridDim.z;
    unsigned sum, cnt, mine, sp = 0u;
    for (;;) {
        sum = 0u; cnt = 0u; mine = 0u;
#pragma unroll
        for (unsigned j = 0; j < 16; ++j) { const unsigned c = xb_ld(&bar[XB_XCNT(j)]); sum += c; cnt += (c > 0u) ? 1u : 0u; mine = (j == x) ? c : mine; }
        if (sum == G) break;
        __builtin_amdgcn_s_sleep(1);
        if ((++sp & 255u) == 0u) { if (xb_ld(&bar[XB_TMO])) break; if (sp > XB_SPIN_CAP) { atomicAdd(&bar[XB_TMO], 1u); break; } }
    }
    nloc = mine > 0u ? mine : 1u; nx = cnt > 0u ? cnt : 1u;
}
__device__ __forceinline__ void xcd_barrier(const XcdBarrier& b_) {
    XcdBarrier b = b_; b.x = xb_xcc_id();
    asm volatile("s_waitcnt vmcnt(0)" ::: "memory");
    __syncthreads();
    if (threadIdx.x == 0) {
        unsigned* bar = b.bar;
        __builtin_amdgcn_s_waitcnt(0);
        unsigned nloc = b.st[0], nx = b.st[1];
        if (nloc == 0u) { xcd_barrier_complete(bar, b.x, nloc, nx); b.st[0] = nloc; b.st[1] = nx; }
        const unsigned old = xb_add(&bar[XB_XSUB(b.x)], 1u);
        const unsigned gen = old / nloc;
        if (old + 1u == (gen + 1u) * nloc) {
            __builtin_amdgcn_fence(__ATOMIC_RELEASE, "agent");
            asm volatile("s_waitcnt vmcnt(0)" ::: "memory");
            const unsigned og = xb_add(&bar[XB_TOP], 1u);
            const unsigned tg = og / nx;
            if (og + 1u == (tg + 1u) * nx) xb_add(&bar[XB_TOPGEN], 1u);
            else XB_SPIN(xb_ld(&bar[XB_TOPGEN]) == tg, bar);
            __builtin_amdgcn_fence(__ATOMIC_ACQUIRE, "agent");
            xb_add(&bar[XB_XGEN(b.x)], 1u);
            asm volatile("s_waitcnt vmcnt(0)" ::: "memory");
        } else {
            XB_SPIN(xb_ld(&bar[XB_XGEN(b.x)]) == gen, bar);
            __builtin_amdgcn_fence(__ATOMIC_ACQUIRE, "agent");
            asm volatile("s_waitcnt vmcnt(0)" ::: "memory");
        }
    }
    __syncthreads();
}

namespace gm {
constexpr int BM = 256, BK = 64, HALF = 128, HTB = HALF * BK * 2, NXCD = 8, WGM = 8;
__host__ __device__ __forceinline__ int lds_byte(int r, int c) { const int st = (r >> 4) * 2 + (c >> 5), rr = r & 15, cc = c & 31, ob = rr * 64 + cc * 2; return st * 1024 + (ob ^ (((ob >> 9) & 1) << 5)); }
__host__ __device__ __forceinline__ void stage_rc(int b, int& R, int& C) { const int st = b / 1024, sb = b % 1024, swz = sb ^ (((sb >> 9) & 1) << 5); R = (st >> 1) * 16 + swz / 64; C = (st & 1) * 32 + (swz % 64) / 2; }
__host__ __device__ __forceinline__ int perm32(int rho) { const int n = rho >> 4, i = rho & 15; return 8 * (i >> 2) + 4 * n + (i & 3); }
struct Unit { int pm, pn; };
struct StaticOrder {
    int nM, nN, nwg, G, c;
    __device__ __forceinline__ void init(int nM_, int nN_, int G_, int c_) { nM = nM_; nN = nN_; nwg = nM * nN; G = G_; c = c_; }
    __device__ __forceinline__ bool next(int i, Unit& u) const {
        const long L = (long)i * G + c; if (L >= nwg) return false;
        int wgid = (int)L; { const int q = nwg / NXCD, r = nwg % NXCD, xcd = wgid % NXCD, off = wgid / NXCD; wgid = (xcd < r ? xcd * (q + 1) : r * (q + 1) + (xcd - r) * q) + off; }
        const int nig = WGM * nN, gid = wgid / nig, fm = gid * WGM, gsz = (nM - fm) < WGM ? (nM - fm) : WGM;
        u.pm = fm + ((wgid % nig) % gsz); u.pn = (wgid % nig) / gsz; return true;
    }
};
typedef f32x4 Acc[2][2][4][2];

template <class P>
__device__ __forceinline__ void gemm_phase(LAS unsigned char* lds, const P& p, int G, int cid, int tid) {
    constexpr bool GA = P::GA, GB = P::GB;
    const int wid = __builtin_amdgcn_readfirstlane(tid >> 6), lane = tid & 63, wr = wid >> 2, wc = wid & 3, fr = lane & 15, fq = lane >> 4;
    constexpr int K = P::K, nt = K / BK;
    static_assert(nt >= 2 && (nt % 2) == 0, "K must be a multiple of 128");
    unsigned vA[2], vB[2];
#pragma unroll
    for (int i = 0; i < 2; ++i) { int R, C; stage_rc(tid * 16 + i * 8192, R, C); const int Rb = (R & ~31) + perm32(R & 31); vA[i] = (unsigned)(R * P::ldA + C) * 2u; vB[i] = (unsigned)(Rb * P::ldB + C) * 2u; }
    constexpr size_t hsA = (size_t)HALF * P::ldA * 2, hsB = (size_t)HALF * P::ldB * 2;
    const unsigned ldsw = (unsigned)wid * 1024u;
    const int aoff = lds_byte(wr * 64 + fr, fq * 8), boff = lds_byte(wc * 32 + fr, fq * 8);
    unsigned gA[2][2], gB[2][2]; int preA[2][2];
#define G_GATHER_A(U, USEPRE) do { int _tz = threadIdx.x; asm volatile("" : "+v"(_tz)); _Pragma("unroll") for (int _i = 0; _i < 2; ++_i) { int _R, _C; stage_rc(_tz * 16 + _i * 8192, _R, _C); \
        _Pragma("unroll") for (int _h = 0; _h < 2; ++_h) { const int _row = (USEPRE) ? preA[_h][_i] : p.rowA(U, _h * HALF + _R); gA[_h][_i] = (unsigned)(_row * P::ldA + _C) * 2u; } } } while (0)
#define G_GATHER_B(U) do { int _tz = threadIdx.x; asm volatile("" : "+v"(_tz)); _Pragma("unroll") for (int _i = 0; _i < 2; ++_i) { int _R, _C; stage_rc(_tz * 16 + _i * 8192, _R, _C); const int _Rb = (_R & ~31) + perm32(_R & 31); \
        _Pragma("unroll") for (int _h = 0; _h < 2; ++_h) gB[_h][_i] = (unsigned)(p.rowB(U, _h * HALF + _Rb) * P::ldB + _C) * 2u; } } while (0)
#define G_PREF_A(U) do { int _tz = threadIdx.x; asm volatile("" : "+v"(_tz)); _Pragma("unroll") for (int _i = 0; _i < 2; ++_i) { int _R, _C; stage_rc(_tz * 16 + _i * 8192, _R, _C); \
        _Pragma("unroll") for (int _h = 0; _h < 2; ++_h) preA[_h][_i] = p.rowA(U, _h * HALF + _R); } } while (0)
#define G_SA(b, h) (((b) * 2 + (h)) * HTB)
#define G_SB(b, h) ((4 + (b) * 2 + (h)) * HTB)
#define G_GLDS(src, dstoff) __builtin_amdgcn_global_load_lds((const unsigned*)(src), (LAS unsigned*)(lds + (dstoff)), 16, 0, 0)
#define G_KT(kt) (P::KWRAP ? ((kt) >= P::KWRAP ? (kt) - P::KWRAP : (kt)) : (kt))
#define G_STAGE_A(bufoff, h, kt) do { const char* _b = GA ? (cA + (size_t)G_KT(kt) * 128) : (cA + (size_t)(h) * hsA + (size_t)G_KT(kt) * 128); \
        G_GLDS(_b + (GA ? gA[h][0] : vA[0]), (bufoff) + ldsw); G_GLDS(_b + (GA ? gA[h][1] : vA[1]), (bufoff) + ldsw + 8192); } while (0)
#define G_STAGE_B(bufoff, h, kt) do { const char* _b = GB ? (cB + (size_t)G_KT(kt) * 128) : (cB + (size_t)(h) * hsB + (size_t)G_KT(kt) * 128); \
        G_GLDS(_b + (GB ? gB[h][0] : vB[0]), (bufoff) + ldsw); G_GLDS(_b + (GB ? gB[h][1] : vB[1]), (bufoff) + ldsw + 8192); } while (0)
#define G_LDA(dst, b, h) do { _Pragma("unroll") for (int m = 0; m < 4; ++m) _Pragma("unroll") for (int k = 0; k < 2; ++k) dst[m][k] = *(const LAS bf16x8*)(lds + G_SA(b, h) + aoff + m * 2048 + k * 1024); } while (0)
#define G_LDB(dst, b, h) do { _Pragma("unroll") for (int n = 0; n < 2; ++n) _Pragma("unroll") for (int k = 0; k < 2; ++k) dst[n][k] = *(const LAS bf16x8*)(lds + G_SB(b, h) + boff + n * 2048 + k * 1024); } while (0)
#define G_CAT(x) __builtin_shufflevector(__builtin_bit_cast(v4i32, (x)[0]), __builtin_bit_cast(v4i32, (x)[1]), 0, 1, 2, 3, 4, 5, 6, 7)
#define G_MMA(ai, bj, At, Bt) do { __builtin_amdgcn_s_setprio(1); _Pragma("unroll") for (int m = 0; m < 4; ++m) _Pragma("unroll") for (int n = 0; n < 2; ++n) { \
        if constexpr (P::FP8) { acc[ai][bj][m][n] = __builtin_amdgcn_mfma_scale_f32_16x16x128_f8f6f4(G_CAT(Bt[n]), G_CAT(At[m]), acc[ai][bj][m][n], 0, 0, 0, P::SCALE_B, 0, P::SCALE_A); } \
        else { _Pragma("unroll") for (int k = 0; k < 2; ++k) acc[ai][bj][m][n] = __builtin_amdgcn_mfma_f32_16x16x32_bf16(Bt[n][k], At[m][k], acc[ai][bj][m][n], 0, 0, 0); } } \
        __builtin_amdgcn_s_setprio(0); } while (0)
#define G_WAIT_V(n) asm volatile("s_waitcnt vmcnt(" #n ")" ::: "memory")
#define G_WAIT_L(n) asm volatile("s_waitcnt lgkmcnt(" #n ")" ::: "memory")
#define G_BAR __builtin_amdgcn_s_barrier()
#define G_SCHED __builtin_amdgcn_sched_barrier(0)
    StaticOrder S; S.init(P::nM, P::nN, G, cid);
    Unit cur, nxt; int ui = 0;
    if (!S.next(0, cur)) return;
    Acc acc;
#pragma unroll
    for (int a = 0; a < 2; ++a)
#pragma unroll
        for (int b = 0; b < 2; ++b)
#pragma unroll
            for (int m = 0; m < 4; ++m)
#pragma unroll
                for (int n = 0; n < 2; ++n) acc[a][b][m][n] = (f32x4){0.f, 0.f, 0.f, 0.f};
    bf16x8 At[4][2], B0[2][2], B1[2][2];
    const char* cA = p.tileA(cur); const char* cB = p.tileB(cur);
    if constexpr (GA) { G_GATHER_A(cur, false); }
    if constexpr (GB) { G_GATHER_B(cur); }
    if constexpr (GA) { VM_WAIT(); }
    G_STAGE_B(G_SB(0, 0), 0, 0); G_STAGE_B(G_SB(0, 1), 1, 0); G_STAGE_A(G_SA(0, 0), 0, 0); G_STAGE_A(G_SA(0, 1), 1, 0);
    if (wr == 1) G_BAR;
    G_WAIT_V(2); G_BAR;
    G_STAGE_B(G_SB(1, 0), 0, 1); G_STAGE_A(G_SA(1, 0), 0, 1); G_STAGE_B(G_SB(1, 1), 1, 1);
    G_WAIT_V(6); G_BAR;
    for (;;) {
        const bool has_next = S.next(ui + 1, nxt);
        { size_t _z = 0; asm volatile("" : "+s"(_z)); cA += _z; cB += _z; }
        const char* nA = has_next ? p.tileA(nxt) : cA; const char* nB = has_next ? p.tileB(nxt) : cB;
        if constexpr (GA && P::PREFA) { if (has_next && nxt.pm != cur.pm) { G_PREF_A(nxt); asm volatile("" : "+v"(preA[0][0]), "+v"(preA[0][1]), "+v"(preA[1][0]), "+v"(preA[1][1])); } }
        int ntr = nt; asm volatile("" : "+s"(ntr));
#pragma nounroll
        for (int t = 0; t < ntr; t += 2) {
            const bool last = (t == ntr - 2);
            asm volatile("" : "+v"(vA[0]), "+v"(vA[1]), "+v"(vB[0]), "+v"(vB[1]));
            if constexpr (GA) asm volatile("" : "+v"(gA[0][0]), "+v"(gA[0][1]), "+v"(gA[1][0]), "+v"(gA[1][1]));
            if constexpr (GB) asm volatile("" : "+v"(gB[0][0]), "+v"(gB[0][1]), "+v"(gB[1][0]), "+v"(gB[1][1]));
            if constexpr (P::HOOK_KT > 0) { if (t == P::HOOK_KT) { int tz = threadIdx.x; asm volatile("" : "+v"(tz)); const int wid2 = tz >> 6, lane2 = tz & 63; p.hook(acc, cur, wid2 >> 2, wid2 & 3, lane2 & 15, lane2 >> 4); } }
            G_LDB(B0, 0, 0); G_LDB(B1, 0, 1); G_SCHED; G_LDA(At, 0, 0); G_STAGE_A(G_SA(1, 1), 1, t + 1);
            G_WAIT_V(8); G_WAIT_L(0); G_BAR; G_MMA(0, 0, At, B0); G_MMA(0, 1, At, B1); G_BAR; G_SCHED;
            int kb = t + 2;
            if (last) {
                kb = 0;
                if (has_next) {
                    cA = nA; cB = nB;
                    if constexpr (GA) { if (!P::PREFA || nxt.pm != cur.pm) G_GATHER_A(nxt, P::PREFA); }
                    if constexpr (GB) { G_GATHER_B(nxt); }
                }
            }
            G_LDA(At, 0, 1); G_STAGE_B(G_SB(0, 0), 0, kb); G_STAGE_B(G_SB(0, 1), 1, kb); G_STAGE_A(G_SA(0, 0), 0, kb);
            G_WAIT_V(8); G_WAIT_L(0); G_BAR; G_MMA(1, 0, At, B0); G_MMA(1, 1, At, B1); G_BAR; G_SCHED;
            G_LDB(B0, 1, 0); G_LDB(B1, 1, 1); G_SCHED; G_LDA(At, 1, 0); G_STAGE_A(G_SA(0, 1), 1, kb);
            G_WAIT_V(8); G_WAIT_L(0); G_BAR; G_MMA(0, 0, At, B0); G_MMA(0, 1, At, B1); G_BAR; G_SCHED;
            G_LDA(At, 1, 1); G_STAGE_B(G_SB(1, 0), 0, kb + 1); G_STAGE_B(G_SB(1, 1), 1, kb + 1); G_STAGE_A(G_SA(1, 0), 0, kb + 1);
            G_WAIT_V(8); G_WAIT_L(0); G_BAR; G_MMA(1, 0, At, B0); G_MMA(1, 1, At, B1); G_BAR; G_SCHED;
        }
        if (wr == 0) G_BAR;
        { int tz = threadIdx.x; asm volatile("" : "+v"(tz));
          const int wid2 = tz >> 6, lane2 = tz & 63; p.epi(acc, cur, wid2 >> 2, wid2 & 3, lane2 & 15, lane2 >> 4); }
        if (!has_next) break;
#pragma unroll
        for (int a = 0; a < 2; ++a)
#pragma unroll
            for (int b = 0; b < 2; ++b)
#pragma unroll
                for (int m = 0; m < 4; ++m)
#pragma unroll
                    for (int n = 0; n < 2; ++n) acc[a][b][m][n] = (f32x4){0.f, 0.f, 0.f, 0.f};
        cur = nxt; ++ui;
        if (wr == 1) G_BAR;
    }
    G_WAIT_V(0);
    G_BAR;
#undef G_GATHER_A
#undef G_GATHER_B
#undef G_PREF_A
#undef G_SA
#undef G_SB
#undef G_GLDS
#undef G_STAGE_A
#undef G_STAGE_B
#undef G_LDA
#undef G_LDB
#undef G_MMA
#undef G_CAT
#undef G_WAIT_V
#undef G_WAIT_L
#undef G_BAR
#undef G_SCHED
}
}
using gm::Unit; using gm::Acc;

struct PInM {
    static constexpr bool GA = false, GB = false, PREFA = false, FP8 = false; static constexpr int SCALE_A = 0, SCALE_B = 0, KWRAP = 0; static constexpr int HOOK_KT = 0, K = D, ldA = D, ldB = D, nM = T / 256, nN = 11;
    const bf16_t* A; const bf16_t* B; bf16_t *Q, *Kb, *VT, *GR, *GBt;
    __device__ __forceinline__ const char* tileA(const Unit& u) const { return (const char*)A + (size_t)u.pm * 256 * ldA * 2; }
    __device__ __forceinline__ const char* tileB(const Unit& u) const { return (const char*)B + (size_t)u.pn * 256 * ldB * 2; }
    __device__ __forceinline__ int rowA(const Unit&, int) const { return 0; }
    __device__ __forceinline__ int rowB(const Unit&, int) const { return 0; }
    __device__ __forceinline__ void hook(Acc&, const Unit&, int, int, int, int) const {}
    __device__ __forceinline__ void epi(const Acc& acc, const Unit& u, int wr, int wc, int fr, int fq) const {
        const int row0 = u.pm * 256 + wr * 64 + fr, cw = wc * 32 + 8 * fq;
        if (u.pn < 2) {
#pragma unroll
            for (int ai = 0; ai < 2; ++ai)
#pragma unroll
                for (int m = 0; m < 4; ++m) { bf16_t* rp = Q + (size_t)(row0 + ai * 128 + m * 16) * AW + u.pn * 256 + cw;
#pragma unroll
                    for (int bj = 0; bj < 2; ++bj) *(u32x4*)(rp + bj * 128) = pack8(acc[ai][bj][m][0], acc[ai][bj][m][1]); }
        } else if (u.pn == 2) {
#pragma unroll
            for (int ai = 0; ai < 2; ++ai)
#pragma unroll
                for (int m = 0; m < 4; ++m) { const int row = row0 + ai * 128 + m * 16;
                    *(u32x4*)(Kb + (size_t)row * KVW + cw) = pack8(acc[ai][0][m][0], acc[ai][0][m][1]);
                    const int b = row >> 14, s = row & (SEQ - 1);
#pragma unroll
                    for (int n = 0; n < 2; ++n)
#pragma unroll
                        for (int j = 0; j < 4; ++j) VT[(size_t)(b * KVW + cw + 4 * n + j) * SEQ + s] = (bf16_t)f2bf(acc[ai][1][m][n][j]); }
        } else {
            const int cc = (u.pn - 3) * 128 + cw;
#pragma unroll
            for (int ai = 0; ai < 2; ++ai)
#pragma unroll
                for (int m = 0; m < 4; ++m) { const size_t o = (size_t)(row0 + ai * 128 + m * 16) * D + cc; f32x4 r[2], s[2];
#pragma unroll
                    for (int n = 0; n < 2; ++n)
#pragma unroll
                        for (int j = 0; j < 4; ++j) { const float ta = 1.f + fexp2(fminf(-acc[ai][0][m][n][j], 100.f)), tb = 1.f + fexp2(fminf(-acc[ai][1][m][n][j], 100.f));
                            s[n][j] = frcp(tb); r[n][j] = tb * frcp(ta); }
                    *(u32x4*)(GR + o) = pack8(r[0], r[1]); *(u32x4*)(GBt + o) = pack8(s[0], s[1]); }
        }
    }
};
struct PInF {
    static constexpr bool GA = false, GB = true, PREFA = false, FP8 = false; static constexpr int SCALE_A = 0, SCALE_B = 0, KWRAP = 0; static constexpr int HOOK_KT = 0, K = D, ldA = D, ldB = D, nM = 2, nN = T / 256;
    const bf16_t* A; const bf16_t* B; bf16_t* FT;
    __device__ __forceinline__ const char* tileA(const Unit& u) const { return (const char*)A + (size_t)u.pm * 256 * ldA * 2; }
    __device__ __forceinline__ const char* tileB(const Unit&) const { return (const char*)B; }
    __device__ __forceinline__ int rowA(const Unit&, int) const { return 0; }
    __device__ __forceinline__ int rowB(const Unit& u, int c) const { const int np = u.pn * 256 + c, b = np >> 14, n2 = np & (SEQ - 1); return b * SEQ + (n2 & 127) * 128 + (n2 >> 7); }
    __device__ __forceinline__ void hook(Acc&, const Unit&, int, int, int, int) const {}
    __device__ __forceinline__ void epi(const Acc& acc, const Unit& u, int wr, int wc, int fr, int fq) const {
        const int ch0 = u.pm * 256 + wr * 64 + fr, b = u.pn >> 6, nc = (u.pn & 63) * 256 + wc * 32 + 8 * fq;
#pragma unroll
        for (int ai = 0; ai < 2; ++ai)
#pragma unroll
            for (int m = 0; m < 4; ++m) { bf16_t* rp = FT + (size_t)(b * FW + ch0 + ai * 128 + m * 16) * SEQ + nc;
#pragma unroll
                for (int bj = 0; bj < 2; ++bj) *(u32x4*)(rp + bj * 128) = pack8(acc[ai][bj][m][0], acc[ai][bj][m][1]); }
    }
};
struct PF1 {
    static constexpr bool GA = false, GB = false, PREFA = false, FP8 = false; static constexpr int SCALE_A = 0, SCALE_B = 0, KWRAP = 0; static constexpr int HOOK_KT = 0, K = 128, ldA = 128, ldB = 128, nM = 1, nN = BATCH * FW * 128 / 256;
    const bf16_t* A; const bf16_t* B; bf16_t* QP; const float* twc; const float* tws;
    __device__ __forceinline__ const char* tileA(const Unit&) const { return (const char*)A; }
    __device__ __forceinline__ const char* tileB(const Unit& u) const { return (const char*)B + (size_t)u.pn * 256 * ldB * 2; }
    __device__ __forceinline__ int rowA(const Unit&, int) const { return 0; }
    __device__ __forceinline__ int rowB(const Unit&, int) const { return 0; }
    __device__ __forceinline__ void hook(Acc&, const Unit&, int, int, int, int) const {}
    __device__ __forceinline__ void epi(const Acc& acc, const Unit& u, int wr, int wc, int fr, int fq) const {
        const int cw = wc * 32 + 8 * fq;
        f32x4 c[4][2], s[4][2];
#pragma unroll
        for (int m = 0; m < 4; ++m) { const int klo = wr * 64 + m * 16 + fr;
#pragma unroll
            for (int n = 0; n < 2; ++n) { c[m][n] = *(const f32x4*)(twc + klo * 128 + cw + 4 * n); s[m][n] = *(const f32x4*)(tws + klo * 128 + cw + 4 * n); } }
#pragma unroll
        for (int m = 0; m < 4; ++m) { const int klo = wr * 64 + m * 16 + fr;
#pragma unroll
            for (int bj = 0; bj < 2; ++bj) { f32x4 qr[2], qi[2];
#pragma unroll
                for (int n = 0; n < 2; ++n) { const f32x4 pr = acc[0][bj][m][n], pi = acc[1][bj][m][n]; qr[n] = pr * c[m][n] + pi * s[m][n]; qi[n] = pi * c[m][n] - pr * s[m][n]; }
                bf16_t* rp = QP + ((size_t)((u.pn * 2 + bj) * 128 + klo) * 2) * 128 + cw;
                *(u32x4*)(rp) = pack8(qr[0], qr[1]); *(u32x4*)(rp + 128) = pack8(qi[0], qi[1]); } }
    }
};
struct PF2 {
    static constexpr bool GA = false, GB = true, PREFA = false, FP8 = false; static constexpr int SCALE_A = 0, SCALE_B = 0, KWRAP = 0; static constexpr int HOOK_KT = 0, K = 256, ldA = 256, ldB = 256, nM = 1, nN = 512;
    const bf16_t* A; const bf16_t* B; bf16_t* AH;
    __device__ __forceinline__ const char* tileA(const Unit&) const { return (const char*)A; }
    __device__ __forceinline__ const char* tileB(const Unit&) const { return (const char*)B; }
    __device__ __forceinline__ int rowA(const Unit&, int) const { return 0; }
    __device__ __forceinline__ int rowB(const Unit& u, int c) const { const int b = u.pn >> 8, chq = (u.pn >> 6) & 3, klo = (u.pn & 63) * 2 + (c >> 7), ch = chq * 128 + (c & 127); return (b * FW + ch) * 128 + klo; }
    __device__ __forceinline__ void hook(Acc&, const Unit&, int, int, int, int) const {}
    __device__ __forceinline__ void epi(const Acc& acc, const Unit& u, int wr, int wc, int fr, int fq) const {
        const int b = u.pn >> 8, chq = (u.pn >> 6) & 3, klo0 = (u.pn & 63) * 2, ch = chq * 128 + wc * 32 + 8 * fq;
#pragma unroll
        for (int ai = 0; ai < 2; ++ai)
#pragma unroll
            for (int m = 0; m < 4; ++m) { const int khi = wr * 64 + m * 16 + fr;
#pragma unroll
                for (int bj = 0; bj < 2; ++bj) { const int tok = b * SEQ + 128 * khi + klo0 + bj;
                    *(u32x4*)(AH + (size_t)tok * AHW + 512 + ai * 512 + ch) = pack8(acc[ai][bj][m][0], acc[ai][bj][m][1]); } }
    }
};
struct PMg {
    static constexpr bool GA = false, GB = false, PREFA = false, FP8 = false; static constexpr int SCALE_A = 0, SCALE_B = 0, KWRAP = 0; static constexpr int HOOK_KT = 8, K = AHW, ldA = AHW, ldB = AHW, nM = T / 256, nN = 4;
    const bf16_t* A; const bf16_t* B; const bf16_t* GR; const bf16_t* GBt; bf16_t* MG;
    __device__ __forceinline__ const char* tileA(const Unit& u) const { return (const char*)A + (size_t)u.pm * 256 * ldA * 2; }
    __device__ __forceinline__ const char* tileB(const Unit& u) const { return (const char*)B + (size_t)u.pn * 256 * ldB * 2; }
    __device__ __forceinline__ int rowA(const Unit&, int) const { return 0; }
    __device__ __forceinline__ int rowB(const Unit&, int) const { return 0; }
    __device__ __forceinline__ void hook(Acc& acc, const Unit& u, int wr, int wc, int fr, int fq) const {
        const size_t o0 = (size_t)(u.pm * 256 + wr * 64 + fr) * D + u.pn * 256 + wc * 32 + 8 * fq;
        u32x4 w[2][4][2];
#pragma unroll
        for (int ai = 0; ai < 2; ++ai)
#pragma unroll
            for (int m = 0; m < 4; ++m)
#pragma unroll
                for (int bj = 0; bj < 2; ++bj) w[ai][m][bj] = *(const u32x4*)(GR + o0 + (size_t)(ai * 128 + m * 16) * D + bj * 128);
#pragma unroll
        for (int ai = 0; ai < 2; ++ai)
#pragma unroll
            for (int m = 0; m < 4; ++m)
#pragma unroll
                for (int bj = 0; bj < 2; ++bj) { f32x4 r0, r1; unpack8(w[ai][m][bj], r0, r1); acc[ai][bj][m][0] *= r0; acc[ai][bj][m][1] *= r1; }
    }
    __device__ __forceinline__ void epi(const Acc& acc, const Unit& u, int wr, int wc, int fr, int fq) const {
        const size_t o0 = (size_t)(u.pm * 256 + wr * 64 + fr) * D + u.pn * 256 + wc * 32 + 8 * fq;
        u32x4 w[2][4][2];
#pragma unroll
        for (int ai = 0; ai < 2; ++ai)
#pragma unroll
            for (int m = 0; m < 4; ++m)
#pragma unroll
                for (int bj = 0; bj < 2; ++bj) w[ai][m][bj] = *(const u32x4*)(GBt + o0 + (size_t)(ai * 128 + m * 16) * D + bj * 128);
#pragma unroll
        for (int ai = 0; ai < 2; ++ai)
#pragma unroll
            for (int m = 0; m < 4; ++m)
#pragma unroll
                for (int bj = 0; bj < 2; ++bj) { f32x4 s0, s1; unpack8(w[ai][m][bj], s0, s1);
                    *(u32x4*)(MG + o0 + (size_t)(ai * 128 + m * 16) * D + bj * 128) = pack8(acc[ai][bj][m][0] * s0, acc[ai][bj][m][1] * s1); }
    }
};
struct POut {
    static constexpr bool GA = false, GB = false, PREFA = false, FP8 = false; static constexpr int SCALE_A = 0, SCALE_B = 0, KWRAP = 0; static constexpr int HOOK_KT = 0, K = D, ldA = D, ldB = D, nM = T / 256, nN = 4;
    const bf16_t* A; const bf16_t* B; const float* xin32; bf16_t* xb;
    __device__ __forceinline__ const char* tileA(const Unit& u) const { return (const char*)A + (size_t)u.pm * 256 * ldA * 2; }
    __device__ __forceinline__ const char* tileB(const Unit& u) const { return (const char*)B + (size_t)u.pn * 256 * ldB * 2; }
    __device__ __forceinline__ int rowA(const Unit&, int) const { return 0; }
    __device__ __forceinline__ int rowB(const Unit&, int) const { return 0; }
    __device__ __forceinline__ void hook(Acc&, const Unit&, int, int, int, int) const {}
    __device__ __forceinline__ void epi(const Acc& acc, const Unit& u, int wr, int wc, int fr, int fq) const {
        const size_t o0 = (size_t)(u.pm * 256 + wr * 64 + fr) * D + u.pn * 256 + wc * 32 + 8 * fq;
        if (xin32) {
#pragma unroll
            for (int ai = 0; ai < 2; ++ai) {
                f32x4 xv[4][2][2];
#pragma unroll
                for (int m = 0; m < 4; ++m)
#pragma unroll
                    for (int bj = 0; bj < 2; ++bj) { const size_t o = o0 + (size_t)(ai * 128 + m * 16) * D + bj * 128; xv[m][bj][0] = *(const f32x4*)(xin32 + o); xv[m][bj][1] = *(const f32x4*)(xin32 + o + 4); }
#pragma unroll
                for (int m = 0; m < 4; ++m)
#pragma unroll
                    for (int bj = 0; bj < 2; ++bj) { const size_t o = o0 + (size_t)(ai * 128 + m * 16) * D + bj * 128;
                        *(u32x4*)(xb + o) = pack8(xv[m][bj][0] + acc[ai][bj][m][0], xv[m][bj][1] + acc[ai][bj][m][1]); }
                asm volatile("" ::: "memory");
            }
        } else {
            u32x4 w[2][4][2];
#pragma unroll
            for (int ai = 0; ai < 2; ++ai)
#pragma unroll
                for (int m = 0; m < 4; ++m)
#pragma unroll
                    for (int bj = 0; bj < 2; ++bj) w[ai][m][bj] = *(const u32x4*)(xb + o0 + (size_t)(ai * 128 + m * 16) * D + bj * 128);
#pragma unroll
            for (int ai = 0; ai < 2; ++ai)
#pragma unroll
                for (int m = 0; m < 4; ++m)
#pragma unroll
                    for (int bj = 0; bj < 2; ++bj) { f32x4 x0, x1; unpack8(w[ai][m][bj], x0, x1);
                        *(u32x4*)(xb + o0 + (size_t)(ai * 128 + m * 16) * D + bj * 128) = pack8(x0 + acc[ai][bj][m][0], x1 + acc[ai][bj][m][1]); }
        }
    }
};
constexpr int FK = FFN_FP8 ? 2 : 1;
__device__ __forceinline__ unsigned pk4_fp8(float a, float b, float c, float d) { int r = __builtin_amdgcn_cvt_pk_fp8_f32(a, b, 0, false); r = __builtin_amdgcn_cvt_pk_fp8_f32(c, d, r, true); return (unsigned)r; }
struct PUp {
    static constexpr bool GA = true, GB = false, PREFA = true, FP8 = FFN_FP8 != 0; static constexpr int SCALE_A = 0, SCALE_B = 0, KWRAP = 0;
    static constexpr int HOOK_KT = 0, K = D / FK, ldA = D / FK, ldB = D / FK, nM = NSLOT / 256, nN = 22;
    const bf16_t* A; const bf16_t* B; const int* seltok; bf16_t* ACT;
    __device__ __forceinline__ const char* tileA(const Unit&) const { return (const char*)A; }
    __device__ __forceinline__ const char* tileB(const Unit& u) const { return (const char*)B + (size_t)(u.pm >> 4) * (2 * DFF) * ldB * 2 + (size_t)u.pn * 256 * ldB * 2; }
    __device__ __forceinline__ int rowA(const Unit& u, int r) const { return seltok[u.pm * 256 + r]; }
    __device__ __forceinline__ int rowB(const Unit&, int) const { return 0; }
    __device__ __forceinline__ void hook(Acc&, const Unit&, int, int, int, int) const {}
    __device__ __forceinline__ void epi(const Acc& acc, const Unit& u, int wr, int wc, int fr, int fq) const {
        const int row0 = u.pm * 256 + wr * 64 + fr, cc = u.pn * 128 + wc * 32 + 8 * fq;
#pragma unroll
        for (int ai = 0; ai < 2; ++ai)
#pragma unroll
            for (int m = 0; m < 4; ++m) { f32x4 a[2];
#pragma unroll
                for (int n = 0; n < 2; ++n)
#pragma unroll
                    for (int j = 0; j < 4; ++j) { const float g = acc[ai][0][m][n][j], up = acc[ai][1][m][n][j];
                        if constexpr (FP8) a[n][j] = __builtin_amdgcn_fmed3f((g * up) * (frcp(1.f + fexp2(g * (-1.f / 64.f))) * (1.f / 4096.f)), -448.f, 448.f);
                        else a[n][j] = g * up * frcp(1.f + fexp2(fminf(-g * LOG2E, 80.f))); }
                if constexpr (FP8) { u32x2 w; w.x = pk4_fp8(a[0][0], a[0][1], a[0][2], a[0][3]); w.y = pk4_fp8(a[1][0], a[1][1], a[1][2], a[1][3]);
                    *(u32x2*)((unsigned char*)ACT + (size_t)(row0 + ai * 128 + m * 16) * DFF + cc) = w; }
                else *(u32x4*)(ACT + (size_t)(row0 + ai * 128 + m * 16) * DFF + cc) = pack8(a[0], a[1]); }
    }
};
struct PDn {
    static constexpr bool GA = false, GB = false, PREFA = false, FP8 = FFN_FP8 != 0; static constexpr int SCALE_A = 0, SCALE_B = 0, KWRAP = 0;
    static constexpr int HOOK_KT = 0, K = DFF / FK, ldA = DFF / FK, ldB = DFF / FK, nM = NSLOT / 256, nN = 4;
    const bf16_t* A; const bf16_t* B; const float* selgate; bf16_t* Y;
    __device__ __forceinline__ const char* tileA(const Unit& u) const { return (const char*)A + (size_t)u.pm * 256 * ldA * 2; }
    __device__ __forceinline__ const char* tileB(const Unit& u) const { return (const char*)B + (size_t)(u.pm >> 4) * D * ldB * 2 + (size_t)u.pn * 256 * ldB * 2; }
    __device__ __forceinline__ int rowA(const Unit&, int) const { return 0; }
    __device__ __forceinline__ int rowB(const Unit&, int) const { return 0; }
    __device__ __forceinline__ void hook(Acc&, const Unit&, int, int, int, int) const {}
    __device__ __forceinline__ void epi(const Acc& acc, const Unit& u, int wr, int wc, int fr, int fq) const {
        const int row0 = u.pm * 256 + wr * 64 + fr, cc = u.pn * 256 + wc * 32 + 8 * fq;
#pragma unroll
        for (int ai = 0; ai < 2; ++ai)
#pragma unroll
            for (int m = 0; m < 4; ++m) { const int row = row0 + ai * 128 + m * 16; const float g = selgate[row] * (FP8 ? (1.f / 256.f) : 1.f);
#pragma unroll
                for (int bj = 0; bj < 2; ++bj) *(u32x4*)(Y + (size_t)row * D + cc + bj * 128) = pack8(acc[ai][bj][m][0] * g, acc[ai][bj][m][1] * g); }
    }
};

struct Args { const float* in[14]; float* out; unsigned char* ws; int ph_lo, ph_hi, li, pad; };
struct Frame {
    LAS unsigned char* lds; volatile LAS unsigned* MISC; unsigned* ctl; unsigned char* ws;
    int tid, lane, wave, vcu, G, bid;
};
__device__ __forceinline__ bf16_t* wsb(const Frame& F, size_t off) { return (bf16_t*)(F.ws + off); }

__device__ __forceinline__ void tr_item(const float* src, int ldn, const float* rs, float cs, bf16_t* dptr, int ldd, int lane) {
#pragma unroll 1
    for (int pass = 0; pass < 2; ++pass) {
        f32x4 v[32];
        const float* sp = src + (size_t)(pass * 32) * ldn + 4 * lane;
#pragma unroll
        for (int r = 0; r < 32; ++r) v[r] = __builtin_nontemporal_load((const f32x4*)(sp + (size_t)r * ldn));
#pragma unroll
        for (int r = 0; r < 32; ++r) { const float sc = rs ? rs[pass * 32 + r] * cs : cs; v[r] = v[r] * sc; }
#pragma unroll
        for (int j = 0; j < 4; ++j)
#pragma unroll
            for (int c = 0; c < 4; ++c) { u32x4 w; w.x = cvt_pk_bf16(v[8 * c][j], v[8 * c + 1][j]); w.y = cvt_pk_bf16(v[8 * c + 2][j], v[8 * c + 3][j]); w.z = cvt_pk_bf16(v[8 * c + 4][j], v[8 * c + 5][j]); w.w = cvt_pk_bf16(v[8 * c + 6][j], v[8 * c + 7][j]);
                *(u32x4*)(dptr + (size_t)j * ldd + pass * 32 + 8 * c) = w; }
    }
}
__device__ __forceinline__ void tr_item8(const float* src, int ldn, const float* rs, float cs, unsigned char* dst0, int ldd, int hi_stride, int lane, LAS unsigned char* tile) {
#pragma unroll 1
    for (int pass = 0; pass < 2; ++pass) {
        f32x4 v[32];
        const float* sp = src + (size_t)(pass * 32) * ldn + 4 * lane;
#pragma unroll
        for (int r = 0; r < 32; ++r) v[r] = __builtin_nontemporal_load((const f32x4*)(sp + (size_t)r * ldn));
#pragma unroll
        for (int r = 0; r < 32; ++r) { const float sc = rs ? rs[pass * 32 + r] * cs : cs; v[r] = v[r] * sc; }
#pragma unroll
        for (int j = 0; j < 4; ++j)
#pragma unroll
            for (int c = 0; c < 2; ++c) { u32x4 w; w.x = pk4_fp8(v[16 * c][j], v[16 * c + 1][j], v[16 * c + 2][j], v[16 * c + 3][j]); w.y = pk4_fp8(v[16 * c + 4][j], v[16 * c + 5][j], v[16 * c + 6][j], v[16 * c + 7][j]);
                w.z = pk4_fp8(v[16 * c + 8][j], v[16 * c + 9][j], v[16 * c + 10][j], v[16 * c + 11][j]); w.w = pk4_fp8(v[16 * c + 12][j], v[16 * c + 13][j], v[16 * c + 14][j], v[16 * c + 15][j]);
                const int row = 4 * lane + j, ch = 2 * pass + c;
                *(LAS u32x4*)(tile + row * 64 + ((ch ^ (lane & 3)) << 4)) = w; }
    }
    LDS_WAIT(); asm volatile("" ::: "memory");
    int lz = lane; asm volatile("" : "+v"(lz));
#pragma unroll
    for (int i = 0; i < 16; ++i) { const int row = 16 * i + (lz >> 2), ch = lz & 3; const u32x4 w = *(const LAS u32x4*)(tile + row * 64 + ((ch ^ ((row >> 2) & 3)) << 4));
        *(u32x4*)(dst0 + (size_t)((row >> 7) * hi_stride + (row & 127)) * ldd + 16 * ch) = w; if ((i & 3) == 3) asm volatile("" ::: "memory"); }
    LDS_WAIT(); asm volatile("" ::: "memory");
}
constexpr int EI_G = NE * 16 * 11, EI_DN = NE * 44 * 4, EI_LAYER = 2 * EI_G + EI_DN;
__device__ __forceinline__ void expert_item(const Frame& F, const Args& a, int l, int r, int lane) {
    const float* g_ffn = a.in[8]; const float* w_eg = a.in[10]; const float* w_eu = a.in[11]; const float* w_ed = a.in[12];
    unsigned char* wl = F.ws + WS_W + (size_t)l * W_LAYER;
    if (r < 2 * EI_G) { const int isu = r >= EI_G; if (isu) r -= EI_G; const int e = r / (16 * 11), r2 = r - e * (16 * 11), kb = r2 / 11, nb = r2 - kb * 11, n = nb * 256 + 4 * lane, k0 = kb * 64;
        const float* src = (isu ? w_eu : w_eg) + ((size_t)(l * NE + e) * D + k0) * DFF + nb * 256;
        if (FFN_FP8) tr_item8(src, DFF, g_ffn + l * D + k0, isu ? 64.f * 4.f / LOG2E : 64.f * LOG2E, (unsigned char*)(wl + WO_GU) + ((size_t)e * (2 * DFF) + 512 * nb + 128 * isu) * D + k0, D, 256, lane, F.lds + F.wave * 16384);
        else tr_item(src, DFF, g_ffn + l * D + k0, 1.f, (bf16_t*)(wl + WO_GU) + ((size_t)e * (2 * DFF) + 256 * (n >> 7) + 128 * isu + (n & 127)) * D + k0, D, lane);
    } else { r -= 2 * EI_G; const int e = r / (44 * 4), r2 = r - e * (44 * 4), kb = r2 >> 2, nb = r2 & 3, n = nb * 256 + 4 * lane, k0 = kb * 64;
        if (FFN_FP8) tr_item8(w_ed + ((size_t)(l * NE + e) * DFF + k0) * D + nb * 256, D, nullptr, 64.f, (unsigned char*)(wl + WO_D) + ((size_t)e * D + nb * 256) * DFF + k0, DFF, 128, lane, F.lds + F.wave * 16384);
        else tr_item(w_ed + ((size_t)(l * NE + e) * DFF + k0) * D + nb * 256, D, nullptr, 1.f, (bf16_t*)(wl + WO_D) + ((size_t)e * D + n) * DFF + k0, DFF, lane); }
}
constexpr int CW_DONE = 8192;
__device__ __forceinline__ void seam_filler(const Frame& F, const Args& a, int k, int need) {
    const int per_layer = (EI_LAYER + F.G - 1) / F.G, total = DEPTH * per_layer;
    volatile LAS int* q = (volatile LAS int*)(F.MISC + 16);
    __syncthreads();
    const int q0 = q[0];
    __syncthreads();
    if (q0 >= total) return;
    if (threadIdx.x == 0) { const unsigned old = __hip_atomic_fetch_add(F.ctl + CW_DONE + 64 * k, 1u, __ATOMIC_RELAXED, __HIP_MEMORY_SCOPE_AGENT); q[1] = (old + 1u == (unsigned)F.G) ? 1 : 0; }
    __syncthreads();
    const int lane = F.lane;
    for (;;) {
        if (q[0] >= need && q[1]) break;
        int it = 0; if (lane == 0) it = __hip_atomic_fetch_add((LAS int*)(F.MISC + 16), 1, __ATOMIC_RELAXED, __HIP_MEMORY_SCOPE_WORKGROUP);
        it = __builtin_amdgcn_readfirstlane(it);
        if (it >= total) break;
        const int l = it / per_layer, loc = it - l * per_layer;
        if (F.vcu * per_layer + loc < EI_LAYER) expert_item(F, a, l, F.vcu * per_layer + loc, lane);
        if (F.wave == 0) { if (__builtin_amdgcn_readfirstlane((int)__hip_atomic_load(F.ctl + CW_DONE + 64 * k, __ATOMIC_RELAXED, __HIP_MEMORY_SCOPE_AGENT)) >= F.G && lane == 0) q[1] = 1; }
    }
}
constexpr int EI_TOTAL = DEPTH * EI_LAYER, EI_R1 = EI_TOTAL % (256 * NWAVES), EI_SLOT = 128 * NWAVES, EI_MAIN = EI_TOTAL - EI_R1 - 2 * EI_SLOT;
static_assert(EI_MAIN % (256 * NWAVES) == 0 && EI_MAIN >= EI_LAYER && EI_R1 <= (256 - BATCH * NE) * NWAVES, "idle-slot item split");
__device__ __forceinline__ int expert_items_main(int G) { return G == 256 ? EI_MAIN : EI_TOTAL; }
__device__ __forceinline__ void expert_slot_inproj(const Frame& F, const Args& a, int layer) {
    if (F.G != 256 || F.bid < 128) return;
    const int it = EI_MAIN + (layer == 0 ? 0 : EI_SLOT) + (F.bid - 128) * NWAVES + F.wave;
    expert_item(F, a, it / EI_LAYER, it % EI_LAYER, F.lane);
}
__device__ __forceinline__ void p0_prologue(const Frame& F, const Args& a) {
    LAS float* cs128 = (LAS float*)(F.lds + RING_BYTES + 4096);
    if (F.tid < 128) { cs128[F.tid] = cospif((float)F.tid / 64.f); cs128[128 + F.tid] = sinpif((float)F.tid / 64.f); }
    __syncthreads();
    const int gw = F.vcu * NWAVES + F.wave, NGW = F.G * NWAVES, lane = F.lane;
    const float* w_in = a.in[3]; const float* g_mix = a.in[2]; const float* w_ap = a.in[5]; const float* w_fp = a.in[6]; const float* w_out = a.in[7];
    const float* g_ffn = a.in[8]; const float* w_router = a.in[9];
    constexpr int I_IN = 16 * 13, I_AP = 8 * 4, I_OUT = 16 * 4;
    constexpr int I_LAYER = I_IN + I_AP + I_OUT;
    for (int it = gw; it < DEPTH * I_LAYER; it += NGW) {
        const int l = it / I_LAYER; int r = it - l * I_LAYER;
        unsigned char* wl = F.ws + WS_W + (size_t)l * W_LAYER;
        if (r < I_IN) { const int kb = r / 13, nb = r - kb * 13, n = nb * 256 + 4 * lane, k0 = kb * 64; bf16_t* dp; float cs = 1.f;
            if (n < 768) { dp = (bf16_t*)(wl + WO_INM) + (size_t)n * D; if (n < 512) cs = 0.125f * LOG2E; }
            else if (n < 1280) dp = (bf16_t*)(wl + WO_F) + (size_t)(n - 768) * D;
            else { const int isb = n >= 2304, c = n - (isb ? 2304 : 1280); dp = (bf16_t*)(wl + WO_INM) + (size_t)(768 + 256 * (c >> 7) + 128 * isb + (c & 127)) * D; cs = LOG2E; }
            tr_item(w_in + (size_t)l * D * INW + (size_t)k0 * INW + nb * 256, INW, g_mix + l * D + k0, cs, dp + k0, D, lane); continue; }
        r -= I_IN;
        if (r < I_AP) { const int kb = r >> 2, nb = r & 3, n = nb * 256 + 4 * lane, k0 = kb * 64;
            tr_item(w_ap + (size_t)l * AW * D + (size_t)k0 * D + nb * 256, D, nullptr, 1.f, (bf16_t*)(wl + WO_MG) + (size_t)n * AHW + k0, AHW, lane); continue; }
        r -= I_AP;
        { const int kb = r >> 2, nb = r & 3, n = nb * 256 + 4 * lane, k0 = kb * 64;
            tr_item(w_out + (size_t)l * D * D + (size_t)k0 * D + nb * 256, D, nullptr, 1.f, (bf16_t*)(wl + WO_OUT) + (size_t)n * D + k0, D, lane); }
    }
    if (MK_N_LAUNCHES != 1 || !USE_FILLER) { const int nmain = expert_items_main(F.G); for (int it = gw; it < nmain; it += NGW) expert_item(F, a, it / EI_LAYER, it % EI_LAYER, lane); }
    for (int it = gw; it < DEPTH * 4 * 16 * 16; it += NGW) {
        const int l = it >> 10, g = (it >> 8) & 3, n2b = (it >> 4) & 15, nb = it & 15, n = nb * 64 + lane, n20 = n2b * 8;
        const float* wp = w_fp + (size_t)l * FW * D + (size_t)(g * 128) * D + n;
        float ac[8], as[8];
#pragma unroll
        for (int i = 0; i < 8; ++i) { ac[i] = 0.f; as[i] = 0.f; }
#pragma unroll 1
        for (int kh = 0; kh < 128; kh += 32) { float wv[32];
#pragma unroll
            for (int q = 0; q < 32; ++q) wv[q] = wp[(size_t)(kh + q) * D];
#pragma unroll
            for (int q = 0; q < 32; ++q) { const int k2 = kh + q;
#pragma unroll
                for (int i = 0; i < 8; ++i) { const int idx = (k2 * (n20 + i)) & 127; ac[i] += cs128[idx] * wv[q]; as[i] += cs128[128 + idx] * wv[q]; } } }
        const float isq = 0.08838834764831845f;
        bf16_t* dst = (bf16_t*)(F.ws + WS_W + (size_t)l * W_LAYER + WO_MG) + (size_t)n * AHW + 512 + g * 128 + n20;
        u32x4 oc, os; oc.x = pk2(ac[0] * isq, ac[1] * isq); oc.y = pk2(ac[2] * isq, ac[3] * isq); oc.z = pk2(ac[4] * isq, ac[5] * isq); oc.w = pk2(ac[6] * isq, ac[7] * isq);
        os.x = pk2(as[0] * isq, as[1] * isq); os.y = pk2(as[2] * isq, as[3] * isq); os.z = pk2(as[4] * isq, as[5] * isq); os.w = pk2(as[6] * isq, as[7] * isq);
        *(u32x4*)dst = oc; *(u32x4*)(dst + 512) = os;
    }
    const int gt = (F.vcu * NTHR + F.tid), NGT = F.G * NTHR; const float isq = 0.08838834764831845f;
    bf16_t* F1 = wsb(F, WS_F1); bf16_t* G2 = wsb(F, WS_G2); float* twc = (float*)(F.ws + WS_TWC); float* tws = (float*)(F.ws + WS_TWS); float* wrt = (float*)(F.ws + WS_WRT);
    for (int i = gt; i < 256 * 128; i += NGT) { const int m = i >> 7, k = i & 127, idx = ((m & 127) * k) & 127; const float v = (m < 128) ? cospif((float)idx / 64.f) : -sinpif((float)idx / 64.f); F1[i] = (bf16_t)f2bf(v * isq); }
    for (int i = gt; i < 256 * 256; i += NGT) { const int m = i >> 8, k = i & 255, ro = m >> 7, ri = k >> 7, idx = ((m & 127) * (k & 127)) & 127; const float c = cospif((float)idx / 64.f), s = sinpif((float)idx / 64.f);
        const float v = (ro == ri) ? c : (ro == 0 ? s : -s); G2[i] = (bf16_t)f2bf(v * isq); }
    for (int i = gt; i < 128 * 128; i += NGT) { const int klo = i >> 7, nlo = i & 127; const float ang = (float)(klo * nlo) / 8192.f; twc[i] = cospif(ang); tws[i] = sinpif(ang); }
    for (int i = gt; i < DEPTH * NE * D; i += NGT) { const int l = i / (NE * D), e = (i / D) % NE, d = i % D; wrt[i] = g_ffn[l * D + d] * w_router[((size_t)l * D + d) * NE + e]; }
}

template <bool SRC32> __device__ __forceinline__ void rp1_load(f32x4 (&d)[4], const float* xsrc32, const bf16_t* xb, int row, int lane) {
    if constexpr (SRC32) {
#pragma unroll
        for (int j = 0; j < 4; ++j) d[j] = *(const f32x4*)(xsrc32 + (size_t)row * D + 4 * lane + 256 * j);
    } else {
#pragma unroll
        for (int j = 0; j < 4; ++j) { const u32x2 w = *(const u32x2*)(xb + (size_t)row * D + 4 * lane + 256 * j); d[j][0] = bflo(w.x); d[j][1] = bfhi(w.x); d[j][2] = bflo(w.y); d[j][3] = bfhi(w.y); }
    }
}
template <bool COMBINE, bool STORE_X, bool FINAL, bool SRC32>
__device__ __forceinline__ void rp1(const Frame& F, const float* xsrc32, float* out32, bf16_t* h, const float* gfin) {
    const int gw = F.vcu * NWAVES + F.wave, NGW = F.G * NWAVES, lane = F.lane;
    const int* slot = (const int*)(F.ws + WS_SLOT); const bf16_t* Y = wsb(F, WS_Y); bf16_t* xb = wsb(F, WS_XB);
    constexpr int R = COMBINE ? 2 : 4;
    int m = gw; f32x4 v[R][4]; int sl[R];
#pragma unroll
    for (int r = 0; r < R; ++r) { sl[r] = -1; if (m + r * NGW < T) { rp1_load<SRC32>(v[r], xsrc32, xb, m + r * NGW, lane); if (COMBINE && lane < NE) sl[r] = slot[(m + r * NGW) * NE + lane]; } }
    for (; m < T; m += R * NGW) {
        const int mn = m + R * NGW; f32x4 nv[R][4]; int nsl[R];
#pragma unroll
        for (int r = 0; r < R; ++r) { nsl[r] = -1; if (mn + r * NGW < T) { rp1_load<SRC32>(nv[r], xsrc32, xb, mn + r * NGW, lane); if (COMBINE && lane < NE) nsl[r] = slot[(mn + r * NGW) * NE + lane]; } }
        if constexpr (COMBINE) {
            unsigned mk[R];
#pragma unroll
            for (int r = 0; r < R; ++r) mk[r] = (unsigned)__ballot(sl[r] >= 0);
            while (mk[0] | mk[R - 1]) {
                u32x2 y[R][2][4]; bool has[R][2];
#pragma unroll
                for (int r = 0; r < R; ++r)
#pragma unroll
                    for (int t = 0; t < 2; ++t) { has[r][t] = mk[r] != 0;
                        if (has[r][t]) { const int e = __builtin_ctz(mk[r]); mk[r] &= mk[r] - 1; const int sr = __builtin_amdgcn_readlane(sl[r], e);
#pragma unroll
                            for (int j = 0; j < 4; ++j) y[r][t][j] = *(const u32x2*)(Y + (size_t)sr * D + 4 * lane + 256 * j); } }
#pragma unroll
                for (int r = 0; r < R; ++r)
#pragma unroll
                    for (int t = 0; t < 2; ++t) if (has[r][t]) {
#pragma unroll
                        for (int j = 0; j < 4; ++j) { v[r][j][0] += bflo(y[r][t][j].x); v[r][j][1] += bfhi(y[r][t][j].x); v[r][j][2] += bflo(y[r][t][j].y); v[r][j][3] += bfhi(y[r][t][j].y); } }
            }
        }
#pragma unroll
        for (int r = 0; r < R; ++r) {
            const int mr = m + r * NGW;
            float ss = 0.f;
#pragma unroll
            for (int j = 0; j < 4; ++j) ss += (v[r][j][0] * v[r][j][0] + v[r][j][1] * v[r][j][1]) + (v[r][j][2] * v[r][j][2] + v[r][j][3] * v[r][j][3]);
            const float rstd = 1.0f / sqrtf(wave_sum(ss) * (1.f / D) + EPS);
            if (mr < T) {
                if constexpr (FINAL) {
#pragma unroll
                    for (int j = 0; j < 4; ++j) { const f32x4 g = *(const f32x4*)(gfin + 4 * lane + 256 * j); *(f32x4*)(out32 + (size_t)mr * D + 4 * lane + 256 * j) = v[r][j] * rstd * g; }
                } else {
                    if constexpr (STORE_X) {
#pragma unroll
                        for (int j = 0; j < 4; ++j) { u32x2 w; w.x = cvt_pk_bf16(v[r][j][0], v[r][j][1]); w.y = cvt_pk_bf16(v[r][j][2], v[r][j][3]); *(u32x2*)(xb + (size_t)mr * D + 4 * lane + 256 * j) = w; }
                    }
#pragma unroll
                    for (int j = 0; j < 4; ++j) { u32x2 w; w.x = cvt_pk_bf16(v[r][j][0] * rstd, v[r][j][1] * rstd); w.y = cvt_pk_bf16(v[r][j][2] * rstd, v[r][j][3] * rstd); *(u32x2*)(h + (size_t)mr * D + 4 * lane + 256 * j) = w; }
                }
            }
        }
#pragma unroll
        for (int r = 0; r < R; ++r) { sl[r] = nsl[r];
#pragma unroll
            for (int j = 0; j < 4; ++j) v[r][j] = nv[r][j]; }
    }
}
__device__ __forceinline__ void rp2(const Frame& F, bf16_t* h, int layer) {
    const bf16_t* xb = wsb(F, WS_XB);
    const int gw = F.vcu * NWAVES + F.wave, NGW = F.G * NWAVES, lane = F.lane;
    LAS float* wl = (LAS float*)F.lds;
    const float* wrt = (const float*)(F.ws + WS_WRT) + (size_t)layer * NE * D;
    for (int i = F.tid; i < NE * D / 4; i += NTHR) ((LAS f32x4*)wl)[i] = ((const f32x4*)wrt)[i];
    __syncthreads();
    float* aff = (float*)(F.ws + WS_AFF); int* slot = (int*)(F.ws + WS_SLOT);
    constexpr int R = 2;
    int m = gw; f32x4 v[R][4];
#pragma unroll
    for (int r = 0; r < R; ++r) if (m + r * NGW < T) {
        rp1_load<false>(v[r], nullptr, xb, m + r * NGW, lane);
    }
    for (; m < T; m += R * NGW) {
        const int mn = m + R * NGW; f32x4 nv[R][4];
#pragma unroll
        for (int r = 0; r < R; ++r) if (mn + r * NGW < T) rp1_load<false>(nv[r], nullptr, xb, mn + r * NGW, lane);
        float rstd[R];
#pragma unroll
        for (int r = 0; r < R; ++r) { float ss = 0.f;
#pragma unroll
            for (int j = 0; j < 4; ++j) ss += (v[r][j][0] * v[r][j][0] + v[r][j][1] * v[r][j][1]) + (v[r][j][2] * v[r][j][2] + v[r][j][3] * v[r][j][3]);
            rstd[r] = 1.0f / sqrtf(wave_sum(ss) * (1.f / D) + EPS); }
#pragma unroll
        for (int r = 0; r < R; ++r) if (m + r * NGW < T) {
#pragma unroll
            for (int j = 0; j < 4; ++j) { const size_t o = (size_t)(m + r * NGW) * D + 4 * lane + 256 * j;
                if (FFN_FP8) *(unsigned*)((unsigned char*)h + o) = pk4_fp8(v[r][j][0] * rstd[r], v[r][j][1] * rstd[r], v[r][j][2] * rstd[r], v[r][j][3] * rstd[r]);
                else { u32x2 w; w.x = cvt_pk_bf16(v[r][j][0] * rstd[r], v[r][j][1] * rstd[r]); w.y = cvt_pk_bf16(v[r][j][2] * rstd[r], v[r][j][3] * rstd[r]); *(u32x2*)(h + o) = w; } }
        }
        float pr[R][NE];
        f32x4 wc[4], wn[4];
#pragma unroll
        for (int j = 0; j < 4; ++j) wc[j] = *(const LAS f32x4*)(wl + 4 * lane + 256 * j);
#pragma unroll
        for (int e = 0; e < NE; ++e) {
            if (e + 1 < NE) {
#pragma unroll
                for (int j = 0; j < 4; ++j) wn[j] = *(const LAS f32x4*)(wl + (e + 1) * D + 4 * lane + 256 * j);
            }
            asm volatile("" ::: "memory");
#pragma unroll
            for (int r = 0; r < R; ++r) { float sacc = 0.f;
#pragma unroll
                for (int j = 0; j < 4; ++j) sacc += (v[r][j][0] * wc[j][0] + v[r][j][1] * wc[j][1]) + (v[r][j][2] * wc[j][2] + v[r][j][3] * wc[j][3]);
                pr[r][e] = sacc; }
            asm volatile("" : "+v"(pr[0][e]), "+v"(pr[1][e]) :: "memory");
#pragma unroll
            for (int j = 0; j < 4; ++j) wc[j] = wn[j];
        }
#pragma unroll
        for (int r = 0; r < R; ++r) {
            float p8[8], p4[4], p2[2], p1;
            { const bool up = (lane & 32) != 0;
#pragma unroll
              for (int i = 0; i < 8; ++i) { const float keep = up ? pr[r][8 + i] : pr[r][i], send = up ? pr[r][i] : pr[r][8 + i]; p8[i] = keep + x32_get(send, up); } }
            { const bool up = (lane & 16) != 0;
#pragma unroll
              for (int i = 0; i < 4; ++i) { const float keep = up ? p8[4 + i] : p8[i], send = up ? p8[i] : p8[4 + i]; p4[i] = keep + x16_get(send, up); } }
            { const bool up = (lane & 8) != 0;
#pragma unroll
              for (int i = 0; i < 2; ++i) { const float keep = up ? p4[2 + i] : p4[i], send = up ? p4[i] : p4[2 + i]; p2[i] = keep + swz_xor<8>(send); } }
            { const bool up = (lane & 4) != 0; const float keep = up ? p2[1] : p2[0], send = up ? p2[0] : p2[1]; p1 = keep + swz_xor<4>(send); }
            p1 += swz_xor<2>(p1); p1 += swz_xor<1>(p1);
            const float lg = p1 * rstd[r]; const int ex_e = ((lane >> 5) & 1) * 8 + ((lane >> 4) & 1) * 4 + ((lane >> 3) & 1) * 2 + ((lane >> 2) & 1);
            float mx = lg; mx = fmaxf(mx, swz_xor<4>(mx)); mx = fmaxf(mx, swz_xor<8>(mx)); mx = x16_max(mx); mx = x32_max(mx);
            const float ex = expf(lg - mx); float den = ex; den += swz_xor<4>(den); den += swz_xor<8>(den); den = x16_sum(den); den = x32_sum(den);
            const int mr = m + r * NGW;
            if ((lane & 3) == 0 && mr < T) { const int b = mr >> 14, sq = mr & (SEQ - 1); aff[(size_t)(b * NE + ex_e) * SEQ + sq] = ex / den; slot[mr * NE + ex_e] = -1; }
        }
#pragma unroll
        for (int r = 0; r < R; ++r)
#pragma unroll
            for (int j = 0; j < 4; ++j) v[r][j] = nv[r][j];
    }
    __syncthreads();
}
__device__ __forceinline__ void topk_phase(const Frame& F, const Args& args_, int layer) {
    if (F.bid >= BATCH * NE) {
        if (layer == 0 && F.G == 256) { const int it = EI_MAIN + 2 * EI_SLOT + (F.bid - BATCH * NE) * NWAVES + F.wave; if (it < EI_TOTAL) expert_item(F, args_, it / EI_LAYER, it % EI_LAYER, F.lane); }
        return;
    }
    const int e = F.bid >> 1, b = F.bid & 1, tid = F.tid, lane = F.lane, wave = F.wave;
    const unsigned* a = (const unsigned*)(F.ws + WS_AFF) + (size_t)(b * NE + e) * SEQ;
    LAS int* red = (LAS int*)F.lds;
    unsigned v[32];
#pragma unroll
    for (int j = 0; j < 8; ++j) { const u32x4 w = *(const u32x4*)(a + 32 * tid + 4 * j); v[4 * j] = w.x; v[4 * j + 1] = w.y; v[4 * j + 2] = w.z; v[4 * j + 3] = w.w; }
    unsigned Tv = 0u; int it = 0;
    for (int bit = 30; bit >= 0; --bit, ++it) {
        const unsigned cand = Tv | (1u << bit); int c = 0;
#pragma unroll
        for (int j = 0; j < 32; ++j) c += (v[j] >= cand) ? 1 : 0;
        c = wave_sum_i(c);
        LAS int* slot = red + (it & 1) * 8;
        if (lane == 0) slot[wave] = c;
        __syncthreads();
        int tot = 0;
#pragma unroll
        for (int w = 0; w < 8; ++w) tot += slot[w];
        if (tot >= CAP) Tv = cand;
    }
    __syncthreads();
    int cg = 0, ce = 0;
#pragma unroll
    for (int j = 0; j < 32; ++j) { cg += (v[j] > Tv) ? 1 : 0; ce += (v[j] == Tv) ? 1 : 0; }
    int sg = cg, se = ce;
#pragma unroll
    for (int o = 1; o < 64; o <<= 1) { const int src = ((lane >= o ? lane - o : lane) << 2); const int tg = __builtin_amdgcn_ds_bpermute(src, sg), te = __builtin_amdgcn_ds_bpermute(src, se); if (lane >= o) { sg += tg; se += te; } }
    LAS int* wtot = red + 16;
    if (lane == 63) { wtot[wave] = sg; wtot[8 + wave] = se; }
    __syncthreads();
    int bg = 0, be = 0, totg = 0;
#pragma unroll
    for (int w = 0; w < 8; ++w) { const int xg = wtot[w], xe = wtot[8 + w]; if (w < wave) { bg += xg; be += xe; } totg += xg; }
    int pg = bg + sg - cg, pe = be + se - ce;
    const int need = CAP - totg;
    const int slotbase = (e * BATCH + b) * CAP;
    int* seltok = (int*)(F.ws + WS_SELTOK); float* selgate = (float*)(F.ws + WS_SELGATE); int* slot = (int*)(F.ws + WS_SLOT);
#pragma unroll
    for (int j = 0; j < 32; ++j) {
        const bool isg = v[j] > Tv, ise = v[j] == Tv;
        const bool sel = isg || (ise && pe < need);
        if (sel) { const int pos = slotbase + pg + (pe < need ? pe : need); const int tok = b * SEQ + 32 * tid + j;
            seltok[pos] = tok; selgate[pos] = __builtin_bit_cast(float, v[j]); slot[tok * NE + e] = pos; }
        pg += isg ? 1 : 0; pe += ise ? 1 : 0;
    }
}

constexpr int AT_K = 0, AT_VT = 49152, AT_VPITCH = 776, AT_TAB = AT_VT + 64 * AT_VPITCH, AT_END = AT_TAB + 4 * 512 * 4;
static_assert(AT_END <= RING_BYTES && (AT_TAB % 16) == 0, "attention LDS");
__device__ __forceinline__ int crow(int r, int hi) { return (r & 3) + 8 * (r >> 2) + 4 * hi; }
__device__ __forceinline__ int t5_bucket(int rel) {
    const int n = rel < 0 ? -rel : rel; const int ret = rel > 0 ? 16 : 0;
    if (n < 8) return ret + n;
    int lg = 8 + (n >= 12) + (n >= 16) + (n >= 23) + (n >= 32) + (n >= 46) + (n >= 64) + (n >= 91);
    return ret + lg;
}
__device__ __forceinline__ void attn_phase(const Frame& F, const bf16_t* Q, const bf16_t* Kb, const bf16_t* VT, bf16_t* AH, const float* rel_bias, const float* sink) {
    LAS unsigned char* lds = F.lds; const int tid = F.tid, lane = F.lane, wave = F.wave;
    LAS float* TAB = (LAS float*)(lds + AT_TAB);
    for (int ui = F.bid; ui < BATCH * 128 * 2; ui += F.G) {
        const int kvh = ui & 1, nb = (ui >> 1) & 127, b = ui >> 8;
        const int s0 = 128 * nb - 128;
        __syncthreads();
#pragma unroll
        for (int i = 0; i < 6; ++i) { const int id = tid + 512 * i, row = id >> 3, ch = id & 7, s = s0 + row;
            u32x4 w = (u32x4){0u, 0u, 0u, 0u}; if (s >= 0 && s < SEQ) w = *(const u32x4*)(Kb + (size_t)(b * SEQ + s) * KVW + kvh * 64 + ch * 8);
            *(LAS u32x4*)(lds + AT_K + row * 128 + ((ch ^ (row & 7)) << 4)) = w; }
#pragma unroll
        for (int i = 0; i < 6; ++i) { const int id = tid + 512 * i, d = id / 48, ch = id - d * 48, s = s0 + 8 * ch;
            u32x4 w = (u32x4){0u, 0u, 0u, 0u}; if (s >= 0 && s < SEQ) w = *(const u32x4*)(VT + (size_t)(b * KVW + kvh * 64 + d) * SEQ + s);
            LAS u32x2* dp = (LAS u32x2*)(lds + AT_VT + d * AT_VPITCH + ch * 16); dp[0] = (u32x2){w.x, w.y}; dp[1] = (u32x2){w.z, w.w}; }
#pragma unroll
        for (int g = 0; g < 4; ++g) { const int rel = tid - 256; TAB[g * 512 + tid] = (rel >= -128 && rel <= 128) ? rel_bias[t5_bucket(rel) * NH + kvh * 4 + g] * LOG2E : -1.0e30f; }
        __syncthreads();
        const int g = wave >> 1, h = kvh * 4 + g, q = lane & 31, hh = lane >> 5;
        const float sk = sink[h] * LOG2E;
        for (int qb = 0; qb < 2; ++qb) {
            const int qoff = (wave & 1) * 64 + qb * 32, qloc = qoff + q; const size_t tok = (size_t)b * SEQ + 128 * nb + qloc;
            bf16x8 qf[4];
#pragma unroll
            for (int ks = 0; ks < 4; ++ks) qf[ks] = *(const bf16x8*)(Q + tok * AW + h * 64 + 16 * ks + 8 * hh);
            float mrun = sk, lrun = 1.f; f32x16 O0, O1;
#pragma unroll
            for (int r = 0; r < 16; ++r) { O0[r] = 0.f; O1[r] = 0.f; }
            int tlo = qoff >> 5, thi = tlo + 8; if (nb == 0 && tlo < 4) tlo = 4; if (nb == 127 && thi > 7) thi = 7;
            const LAS float* tb = TAB + g * 512 + 128 - qloc;
            for (int t = tlo; t <= thi; ++t) {
                f32x16 S;
#pragma unroll
                for (int r = 0; r < 16; ++r) S[r] = tb[32 * t + crow(r, hh)];
                const int krow = 32 * t + q;
#pragma unroll
                for (int ks = 0; ks < 4; ++ks) { const bf16x8 kf = *(const LAS bf16x8*)(lds + AT_K + krow * 128 + (((2 * ks + hh) ^ (krow & 7)) << 4));
                    S = __builtin_amdgcn_mfma_f32_32x32x16_bf16(kf, qf[ks], S, 0, 0, 0); }
                float tmax = -3.0e38f;
#pragma unroll
                for (int r = 0; r < 16; ++r) tmax = fmaxf(tmax, S[r]);
                tmax = x32_max(tmax);
                const float mnew = fmaxf(mrun, tmax), alpha = fexp2(mrun - mnew); mrun = mnew;
                float ps = 0.f;
#pragma unroll
                for (int r = 0; r < 16; ++r) { S[r] = fexp2(S[r] - mnew); ps += S[r]; }
                ps = x32_sum(ps);
                lrun = lrun * alpha + ps;
#pragma unroll
                for (int r = 0; r < 16; ++r) { O0[r] *= alpha; O1[r] *= alpha; }
                u32x4 p0, p1;
                p0.x = cvt_pk_bf16(S[0], S[1]); p0.y = cvt_pk_bf16(S[2], S[3]); p0.z = cvt_pk_bf16(S[4], S[5]); p0.w = cvt_pk_bf16(S[6], S[7]);
                p1.x = cvt_pk_bf16(S[8], S[9]); p1.y = cvt_pk_bf16(S[10], S[11]); p1.z = cvt_pk_bf16(S[12], S[13]); p1.w = cvt_pk_bf16(S[14], S[15]);
                const bf16x8 pf0 = __builtin_bit_cast(bf16x8, p0), pf1 = __builtin_bit_cast(bf16x8, p1);
#pragma unroll
                for (int s = 0; s < 2; ++s) {
                    const int kofs = (32 * t + 16 * s + 4 * hh) * 2;
                    const LAS unsigned char* v0 = lds + AT_VT + q * AT_VPITCH + kofs; const LAS unsigned char* v1 = v0 + 32 * AT_VPITCH;
                    const u32x2 a0 = *(const LAS u32x2*)(v0), a1 = *(const LAS u32x2*)(v0 + 16), c0 = *(const LAS u32x2*)(v1), c1 = *(const LAS u32x2*)(v1 + 16);
                    const bf16x8 vf0 = __builtin_bit_cast(bf16x8, (u32x4){a0.x, a0.y, a1.x, a1.y}), vf1 = __builtin_bit_cast(bf16x8, (u32x4){c0.x, c0.y, c1.x, c1.y});
                    O0 = __builtin_amdgcn_mfma_f32_32x32x16_bf16(vf0, s == 0 ? pf0 : pf1, O0, 0, 0, 0);
                    O1 = __builtin_amdgcn_mfma_f32_32x32x16_bf16(vf1, s == 0 ? pf0 : pf1, O1, 0, 0, 0);
                }
            }
            const float inv = 1.0f / lrun;
            bf16_t* op = AH + tok * AHW + h * 64 + 4 * hh;
#pragma unroll
            for (int r4 = 0; r4 < 4; ++r4) {
                u32x2 w0, w1; w0.x = cvt_pk_bf16(O0[4 * r4] * inv, O0[4 * r4 + 1] * inv); w0.y = cvt_pk_bf16(O0[4 * r4 + 2] * inv, O0[4 * r4 + 3] * inv);
                w1.x = cvt_pk_bf16(O1[4 * r4] * inv, O1[4 * r4 + 1] * inv); w1.y = cvt_pk_bf16(O1[4 * r4 + 2] * inv, O1[4 * r4 + 3] * inv);
                *(u32x2*)(op + 8 * r4) = w0; *(u32x2*)(op + 32 + 8 * r4) = w1; }
        }
    }
    __syncthreads();
}

__device__ __forceinline__ bool in_range(int k, int lo, int hi) { asm volatile("" : "+s"(lo), "+s"(hi)); return lo <= k && k < hi; }
constexpr int PH_PER_LAYER = 10, N_PHASES = 1 + DEPTH * PH_PER_LAYER + 1;
__global__ void __launch_bounds__(NTHR, 2) mk_fwd(Args args) {
    extern __shared__ __attribute__((aligned(16))) unsigned char lds_raw[];
    Frame F;
    F.lds = (LAS unsigned char*)lds_raw; F.MISC = (volatile LAS unsigned*)(F.lds + MISC_OFF);
    F.tid = threadIdx.x; F.lane = F.tid & 63; F.wave = __builtin_amdgcn_readfirstlane(F.tid >> 6);
    F.G = gridDim.x; F.bid = blockIdx.x; F.vcu = F.bid;
    F.ws = args.ws; F.ctl = (unsigned*)(args.ws + WS_CTL);
    for (int u = F.tid; u < (LDS_BYTES - RING_BYTES) / 4; u += NTHR) ((LAS unsigned*)(F.lds + RING_BYTES))[u] = 0u;
    __syncthreads();
    if (MK_N_LAUNCHES == 1) (void)xcd_barrier_post(F.ctl + CW_BAR, F.MISC + 8);
    if (PROBE_MODE && threadIdx.x == 0) { volatile LAS unsigned long long* ps = (volatile LAS unsigned long long*)(F.lds + RING_BYTES + 1024); ps[0] = 0; ps[1] = 0; ps[2] = __builtin_amdgcn_s_memrealtime(); }
    const int lo = args.ph_lo, hi = args.ph_hi;
#if MK_N_LAUNCHES == 1
#define IN(k) true
#else
#define IN(k) in_range((k), lo, hi)
#endif
#define PHASE_BEGIN() do { int _tz = threadIdx.x; asm volatile("" : "+v"(_tz)); F.tid = _tz; F.lane = _tz & 63; size_t _z = 0; int _g = gridDim.x, _b = blockIdx.x; asm volatile("" : "+s"(_z), "+s"(_g), "+s"(_b)); F.ws = args.ws + _z; F.G = _g; F.bid = _b; F.vcu = (_g % 8 == 0) ? (_b % 8) * (_g / 8) + _b / 8 : _b; } while (0)
#define SEAM(k) do { if (IN(k) && IN((k) + 1)) { if (USE_FILLER && MK_N_LAUNCHES == 1 && (k) <= 18) { PHASE_BEGIN(); const int _pl = (EI_LAYER + F.G - 1) / F.G; seam_filler(F, args, (k), (k) >= 18 ? 2 * _pl : ((k) >= 8 ? _pl : 0)); } XcdBarrier _b; _b.bar = (unsigned*)(args.ws + WS_CTL) + CW_BAR; _b.x = 0; _b.st = F.MISC + 8; \
        unsigned long long _t0 = 0; if (PROBE_MODE == 2 && threadIdx.x == 0) _t0 = __builtin_amdgcn_s_memrealtime(); \
        if (PROBE_MODE == 3 && threadIdx.x == 0 && (k) == PROBE_K) { volatile LAS unsigned long long* _ps = (volatile LAS unsigned long long*)(F.lds + RING_BYTES + 1024); _ps[5] = __builtin_amdgcn_s_memtime(); _ps[6] = __builtin_amdgcn_s_memrealtime(); } \
        xcd_barrier(_b); \
        if (PROBE_MODE == 3 && threadIdx.x == 0 && (k) == PROBE_K - 1) { volatile LAS unsigned long long* _ps = (volatile LAS unsigned long long*)(F.lds + RING_BYTES + 1024); _ps[3] = __builtin_amdgcn_s_memtime(); _ps[4] = __builtin_amdgcn_s_memrealtime(); } \
        if (PROBE_MODE && threadIdx.x == 0) { const unsigned long long _t1 = __builtin_amdgcn_s_memrealtime(); volatile LAS unsigned long long* _ps = (volatile LAS unsigned long long*)(F.lds + RING_BYTES + 1024); \
            if (PROBE_MODE == 1) { if ((k) == PROBE_K - 1) _ps[0] = _t1; if ((k) == PROBE_K) _ps[1] = _t1; } else if (PROBE_MODE == 2) { _ps[0] = _ps[0] + (_t1 - _t0); } } } } while (0)
    const float* x_in = args.in[0]; float* xo = args.out;
#define WB(off) wsb(F, (off))
    if (PH_ON(0) && IN(0)) REPS(0) { PHASE_BEGIN(); p0_prologue(F, args); __syncthreads(); }
    if (MK_N_LAUNCHES != 1) SEAM(0);
    for (int l = 0; l < DEPTH; ++l) {
        const int pb = 1 + l * PH_PER_LAYER;
        const size_t wlo = WS_W + (size_t)l * W_LAYER;
        if (PH_ON(1) && IN(pb + 0)) REPS(1) { if (_rep && l) break; PHASE_BEGIN(); if (l == 0) rp1<false, false, false, true>(F, x_in, nullptr, WB(WS_H), nullptr); else rp1<true, true, false, false>(F, nullptr, nullptr, WB(WS_H), nullptr); }
        SEAM(pb + 0);
        if (IN(pb + 1)) {
            if (PH_ON(2)) REPS(2) { PHASE_BEGIN(); PInM p{WB(WS_H), WB(wlo + WO_INM), WB(WS_MIX + MX_Q), WB(WS_MIX + MX_K), WB(WS_MIX + MX_VT), WB(WS_MIX + MX_GR), WB(WS_MIX + MX_GB)}; gm::gemm_phase(F.lds, p, F.G, F.bid, F.tid); }
            if (PH_ON(3)) REPS(3) { PHASE_BEGIN(); PInF p{WB(wlo + WO_F), WB(WS_H), WB(WS_MIX + MX_FT)}; gm::gemm_phase(F.lds, p, F.G, F.bid, F.tid); }
            if (PH_ON(0)) { PHASE_BEGIN(); expert_slot_inproj(F, args, l); }
        }
        SEAM(pb + 1);
        if (IN(pb + 2)) {
            if (PH_ON(4)) REPS(4) { PHASE_BEGIN(); attn_phase(F, WB(WS_MIX + MX_Q), WB(WS_MIX + MX_K), WB(WS_MIX + MX_VT), WB(WS_MIX + MX_AH), args.in[1], args.in[4] + l * NH); }
            if (PH_ON(5)) REPS(5) { PHASE_BEGIN(); PF1 p{WB(WS_F1), WB(WS_MIX + MX_FT), WB(WS_MIX + MX_QP), (const float*)(F.ws + WS_TWC), (const float*)(F.ws + WS_TWS)}; gm::gemm_phase(F.lds, p, F.G, F.bid, F.tid); }
        }
        SEAM(pb + 2);
        if (PH_ON(6) && IN(pb + 3)) REPS(6) { PHASE_BEGIN(); PF2 p{WB(WS_G2), WB(WS_MIX + MX_QP), WB(WS_MIX + MX_AH)}; gm::gemm_phase(F.lds, p, F.G, F.bid, F.tid); }
        SEAM(pb + 3);
        if (PH_ON(7) && IN(pb + 4)) REPS(7) { PHASE_BEGIN(); PMg p{WB(WS_MIX + MX_AH), WB(wlo + WO_MG), WB(WS_MIX + MX_GR), WB(WS_MIX + MX_GB), WB(WS_MIX + MX_MG)}; gm::gemm_phase(F.lds, p, F.G, F.bid, F.tid); }
        SEAM(pb + 4);
        if (PH_ON(8) && IN(pb + 5)) REPS(8) { if (_rep && l) break; PHASE_BEGIN(); POut p{WB(WS_MIX + MX_MG), WB(wlo + WO_OUT), l == 0 ? x_in : (const float*)nullptr, WB(WS_XB)}; gm::gemm_phase(F.lds, p, F.G, F.bid, F.tid); }
        SEAM(pb + 5);
        if (PH_ON(9) && IN(pb + 6)) REPS(9) { PHASE_BEGIN(); rp2(F, WB(WS_H), l); }
        SEAM(pb + 6);
        if (PH_ON(10) && IN(pb + 7)) REPS(10) { PHASE_BEGIN(); topk_phase(F, args, l); }
        SEAM(pb + 7);
        if (PH_ON(11) && IN(pb + 8)) REPS(11) { PHASE_BEGIN(); PUp p{WB(WS_H), WB(wlo + WO_GU), (const int*)(F.ws + WS_SELTOK), WB(WS_ACT)}; gm::gemm_phase(F.lds, p, F.G, F.bid, F.tid); }
        SEAM(pb + 8);
        if (PH_ON(12) && IN(pb + 9)) REPS(12) { PHASE_BEGIN(); PDn p{WB(WS_ACT), WB(wlo + WO_D), (const float*)(F.ws + WS_SELGATE), WB(WS_Y)}; gm::gemm_phase(F.lds, p, F.G, F.bid, F.tid); }
        SEAM(pb + 9);
    }
    if (PH_ON(13) && IN(N_PHASES - 1)) { PHASE_BEGIN(); rp1<true, false, true, false>(F, nullptr, xo, nullptr, args.in[13]); }
#undef WB
    if (PROBE_MODE) {
        volatile LAS unsigned long long* ps = (volatile LAS unsigned long long*)(F.lds + RING_BYTES + 1024);
        unsigned long long* acc64 = (unsigned long long*)(args.ws + WS_CTL) + 1024;
        if (PROBE_MODE == 2) { if (threadIdx.x == 0) atomicAdd(acc64, ps[0]); XcdBarrier _b; _b.bar = (unsigned*)(args.ws + WS_CTL) + CW_BAR; _b.x = 0; _b.st = F.MISC + 8; xcd_barrier(_b); }
        if (blockIdx.x == 0 && threadIdx.x == 0) {
            unsigned long long d;
            if (PROBE_MODE == 1) { const unsigned long long a = (PROBE_K == 0) ? ps[2] : ps[0]; d = ps[1] - a; }
            else if (PROBE_MODE == 3) { const unsigned long long cyc = ps[5] - ps[3], rt = ps[6] - ps[4]; d = (rt ? (cyc * 100ull / rt) : 0ull) * 100ull / PROBE_AMP; }
            else d = __hip_atomic_load(acc64, __ATOMIC_RELAXED, __HIP_MEMORY_SCOPE_AGENT) / gridDim.x;
            const unsigned long long t0 = __builtin_amdgcn_s_memrealtime();
            while (__builtin_amdgcn_s_memrealtime() - t0 < d * PROBE_AMP) __builtin_amdgcn_s_sleep(16);
        }
    }
#undef IN
#undef SEAM
}

extern "C" void kernel_launch(void* const* d_in, const int* in_sizes, int n_in, void* d_out, int out_size, void* d_ws, size_t ws_size, hipStream_t stream) {
    static int grid = 0;
    if (grid == 0) {
        if (n_in != 14 || out_size != T * D || ws_size < WS_END) { fprintf(stderr, "kernel_launch: unexpected shapes (n_in %d out %d ws %zu); nothing launched\n", n_in, out_size, ws_size); grid = -1; return; }
        int dev = 0, cus = 0, per_cu = 0;
        if (hipGetDevice(&dev) != hipSuccess || hipDeviceGetAttribute(&cus, hipDeviceAttributeMultiprocessorCount, dev) != hipSuccess) { grid = -1; return; }
        if (hipFuncSetAttribute((const void*)mk_fwd, hipFuncAttributeMaxDynamicSharedMemorySize, LDS_BYTES) != hipSuccess) { fprintf(stderr, "kernel_launch: hipFuncSetAttribute failed\n"); grid = -1; return; }
        if (hipOccupancyMaxActiveBlocksPerMultiprocessor(&per_cu, (const void*)mk_fwd, NTHR, LDS_BYTES) != hipSuccess || per_cu < 1) fprintf(stderr, "kernel_launch: occupancy query says %d\n", per_cu);
        (void)hipGetLastError();
        grid = cus;
    }
    if (grid < 0) return;
    (void)hipMemsetAsync((char*)d_ws + WS_CTL, 0, CTL_ZERO_BYTES, stream);
    Args a{};
    for (int i = 0; i < 14; ++i) a.in[i] = (const float*)d_in[i];
    a.out = (float*)d_out; a.ws = (unsigned char*)d_ws;
#if MK_N_LAUNCHES == 1
    a.ph_lo = 0; a.ph_hi = N_PHASES; a.li = 0;
    hipLaunchKernelGGL(mk_fwd, dim3(grid), dim3(NTHR), LDS_BYTES, stream, a);
#else
    for (int ph = 0; ph < N_PHASES; ++ph) { a.ph_lo = ph; a.ph_hi = ph + 1; a.li = ph; hipLaunchKernelGGL(mk_fwd, dim3(grid), dim3(NTHR), LDS_BYTES, stream, a); }
#endif
}
```

```cpp
#include <hip/hip_runtime.h>
#include <cstdio>
#include <cstdint>

#define LAS __attribute__((address_space(3)))
#define GAS __attribute__((address_space(1)))
typedef unsigned short bf16_t;
typedef short bf16x8 __attribute__((ext_vector_type(8)));
typedef float f32x4 __attribute__((ext_vector_type(4)));
typedef float f32x16 __attribute__((ext_vector_type(16)));
typedef unsigned u32x4 __attribute__((ext_vector_type(4)));
typedef unsigned u32x2 __attribute__((ext_vector_type(2)));
typedef GAS unsigned gu32;
typedef int v8i32 __attribute__((ext_vector_type(8)));
typedef int v4i32 __attribute__((ext_vector_type(4)));

#ifndef MK_N_LAUNCHES
#define MK_N_LAUNCHES 1
#endif
#ifndef FFN_FP8
#define FFN_FP8 1
#endif
#ifndef USE_FILLER
#define USE_FILLER 0
#endif
#ifndef PH_MASK
#define PH_MASK 0xffff
#endif
#define PH_ON(k) ((PH_MASK >> (k)) & 1)
#ifndef PH_REP
#define PH_REP 0
#endif
#ifndef PROBE_MODE
#define PROBE_MODE 0
#endif
#ifndef PROBE_K
#define PROBE_K 0
#endif
#define PROBE_AMP 4
#define REPS(k) _Pragma("nounroll") for (int _rep = 0; _rep < 1 + ((PH_REP >> (k)) & 1); ++_rep)

constexpr int D = 1024, BATCH = 2, SEQ = 16384, T = BATCH * SEQ, DEPTH = 2;
constexpr int NH = 8, HD = 64, AW = 512, KVW = 128, FW = 512, INW = 3328;
constexpr int NE = 16, CAP = 2048, DFF = 2816, NSLOT = BATCH * NE * CAP;
constexpr float EPS = 1e-6f, LOG2E = 1.4426950408889634f;
constexpr int AHW = 1536;
constexpr int NWAVES = 8, NTHR = 512;

constexpr size_t MiB = 1u << 20, KiB = 1024;
constexpr size_t WS_CTL = 0, CTL_ZERO_BYTES = 1 * MiB;
constexpr size_t WS_F1 = 1 * MiB, WS_G2 = WS_F1 + 64 * KiB, WS_TWC = WS_G2 + 128 * KiB, WS_TWS = WS_TWC + 64 * KiB, WS_WRT = WS_TWS + 64 * KiB,
                 WS_SELTOK = WS_WRT + 128 * KiB, WS_SELGATE = WS_SELTOK + 256 * KiB;
static_assert(WS_SELGATE + 256 * KiB <= 2 * MiB, "misc map");
constexpr size_t WS_AFF = 2 * MiB, WS_SLOT = 4 * MiB;
constexpr size_t WS_W = 8 * MiB, W_LAYER = 276 * MiB;
constexpr size_t WO_INM = 0, WO_F = 6 * MiB, WO_MG = 7 * MiB, WO_OUT = 10 * MiB, WO_GU = 12 * MiB, WO_D = 188 * MiB;
constexpr size_t WS_H = 560 * MiB, WS_Y = 624 * MiB, WS_MIX = 752 * MiB, WS_ACT = 752 * MiB;
constexpr size_t MX_Q = 0, MX_K = 32 * MiB, MX_VT = 40 * MiB, MX_FT = 48 * MiB, MX_GR = 80 * MiB, MX_GB = 144 * MiB, MX_AH = 208 * MiB, MX_QP = 304 * MiB, MX_MG = 368 * MiB;
constexpr size_t WS_XB = 1184 * MiB;
constexpr size_t WS_END = 1248 * MiB;
static_assert(WS_W + 2 * W_LAYER <= WS_H && WS_MIX + MX_MG + 64 * MiB <= WS_END && WS_ACT + (size_t)NSLOT * DFF * 2 <= WS_END, "ws map");

constexpr int CW_BAR = 4096;

constexpr int RING_BYTES = 131072, MISC_OFF = RING_BYTES + 320, LDS_BYTES = 147456;

__device__ __forceinline__ unsigned f2bf(float f) { unsigned u = __builtin_bit_cast(unsigned, f); return (u + 0x7fffu + ((u >> 16) & 1u)) >> 16; }
__device__ __forceinline__ unsigned pk2(float lo, float hi) { return f2bf(lo) | (f2bf(hi) << 16); }
__device__ __forceinline__ unsigned cvt_pk_bf16(float lo, float hi) { unsigned r; asm volatile("v_cvt_pk_bf16_f32 %0, %1, %2" : "=v"(r) : "v"(lo), "v"(hi)); return r; }
__device__ __forceinline__ u32x4 pack8(const f32x4 a, const f32x4 b) { u32x4 w; w.x = cvt_pk_bf16(a[0], a[1]); w.y = cvt_pk_bf16(a[2], a[3]); w.z = cvt_pk_bf16(b[0], b[1]); w.w = cvt_pk_bf16(b[2], b[3]); return w; }
__device__ __forceinline__ float bflo(unsigned w) { return __builtin_bit_cast(float, w << 16); }
__device__ __forceinline__ float bfhi(unsigned w) { return __builtin_bit_cast(float, w & 0xffff0000u); }
__device__ __forceinline__ void unpack8(const u32x4 w, f32x4& a, f32x4& b) { a[0] = bflo(w.x); a[1] = bfhi(w.x); a[2] = bflo(w.y); a[3] = bfhi(w.y); b[0] = bflo(w.z); b[1] = bfhi(w.z); b[2] = bflo(w.w); b[3] = bfhi(w.w); }
__device__ __forceinline__ float fexp2(float x) { return __builtin_amdgcn_exp2f(x); }
__device__ __forceinline__ float frcp(float x) { return __builtin_amdgcn_rcpf(x); }
template <int CTRL> __device__ __forceinline__ float dpp_mov(float v) { return __builtin_bit_cast(float, __builtin_amdgcn_mov_dpp(__builtin_bit_cast(int, v), CTRL, 0xF, 0xF, true)); }
template <int O> __device__ __forceinline__ float swz_xor(float v) {
    if constexpr (O == 1) return dpp_mov<0xB1>(v);
    else if constexpr (O == 2) return dpp_mov<0x4E>(v);
    else if constexpr (O == 4) { int t = __builtin_amdgcn_update_dpp(0, __builtin_bit_cast(int, v), 0x104, 0xF, 0x5, false); t = __builtin_amdgcn_update_dpp(t, __builtin_bit_cast(int, v), 0x114, 0xF, 0xA, false); return __builtin_bit_cast(float, t); }
    else { static_assert(O == 8, "swz_xor: O in {1,2,4,8}"); return dpp_mov<0x128>(v); }
}
__device__ __forceinline__ float x32_sum(float v) { const unsigned u = __builtin_bit_cast(unsigned, v); auto r = __builtin_amdgcn_permlane32_swap(u, u, false, false); return __builtin_bit_cast(float, (unsigned)r[0]) + __builtin_bit_cast(float, (unsigned)r[1]); }
__device__ __forceinline__ float x32_max(float v) { const unsigned u = __builtin_bit_cast(unsigned, v); auto r = __builtin_amdgcn_permlane32_swap(u, u, false, false); return fmaxf(__builtin_bit_cast(float, (unsigned)r[0]), __builtin_bit_cast(float, (unsigned)r[1])); }
__device__ __forceinline__ float x32_get(float v, bool up) { const unsigned u = __builtin_bit_cast(unsigned, v); auto r = __builtin_amdgcn_permlane32_swap(u, u, false, false); return __builtin_bit_cast(float, up ? (unsigned)r[0] : (unsigned)r[1]); }
__device__ __forceinline__ float x16_sum(float v) { const unsigned u = __builtin_bit_cast(unsigned, v); auto r = __builtin_amdgcn_permlane16_swap(u, u, false, false); return __builtin_bit_cast(float, (unsigned)r[0]) + __builtin_bit_cast(float, (unsigned)r[1]); }
__device__ __forceinline__ float x16_max(float v) { const unsigned u = __builtin_bit_cast(unsigned, v); auto r = __builtin_amdgcn_permlane16_swap(u, u, false, false); return fmaxf(__builtin_bit_cast(float, (unsigned)r[0]), __builtin_bit_cast(float, (unsigned)r[1])); }
__device__ __forceinline__ float x16_get(float v, bool odd) { const unsigned u = __builtin_bit_cast(unsigned, v); auto r = __builtin_amdgcn_permlane16_swap(u, u, false, false); return __builtin_bit_cast(float, odd ? (unsigned)r[0] : (unsigned)r[1]); }
__device__ __forceinline__ float wave_sum(float v) { v += dpp_mov<0xB1>(v); v += dpp_mov<0x4E>(v); v += dpp_mov<0x141>(v); v += dpp_mov<0x140>(v); v = x16_sum(v); return x32_sum(v); }
__device__ __forceinline__ int wave_sum_i(int v) { return (int)wave_sum((float)v); }
#define LDS_WAIT() asm volatile("s_waitcnt lgkmcnt(0)" ::: "memory")
#define VM_WAIT() asm volatile("s_waitcnt vmcnt(0)" ::: "memory")

#define XB_TMO      128
#define XB_XCNT(j)  (256  + 64 * (j))
#define XB_XSUB(j)  (1280 + 64 * (j))
#define XB_XGEN(j)  (2304 + 64 * (j))
#define XB_TOP      3328
#define XB_TOPGEN   3392
#define XCD_BAR_WORDS 3456
#define XB_SPIN_CAP (1u << 22)
__device__ __forceinline__ unsigned xb_ld(unsigned* p)              { return __hip_atomic_load(p, __ATOMIC_RELAXED, __HIP_MEMORY_SCOPE_AGENT); }
__device__ __forceinline__ unsigned xb_add(unsigned* p, unsigned v) { return __hip_atomic_fetch_add(p, v, __ATOMIC_RELAXED, __HIP_MEMORY_SCOPE_AGENT); }
__device__ __forceinline__ unsigned xb_xcc_id() { return (unsigned)__builtin_amdgcn_s_getreg((3 << 11) | 20) & 0xFu; }
#define XB_SPIN(cond, bar) do { unsigned _sp = 0; while (cond) { __builtin_amdgcn_s_sleep(1); \
    if ((++_sp & 255u) == 0u) { if (xb_ld(&(bar)[XB_TMO])) break; if (_sp > XB_SPIN_CAP) { atomicAdd(&(bar)[XB_TMO], 1u); break; } } } } while (0)
struct XcdBarrier { unsigned* bar; unsigned x; volatile LAS unsigned* st; };
__device__ __forceinline__ XcdBarrier xcd_barrier_post(unsigned* bar, volatile LAS unsigned* st) {
    XcdBarrier b; b.bar = bar; b.x = xb_xcc_id(); b.st = st;
    if (threadIdx.x == 0) (void)xb_add(&bar[XB_XCNT(b.x)], 1u);
    return b;
}
__device__ __forceinline__ void xcd_barrier_complete(unsigned* bar, unsigned x, unsigned& nloc, unsigned& nx) {
    const unsigned G = gridDim.x * gridDim.y * gridDim.z;
    unsigned sum, cnt, mine, sp = 0u;
    for (;;) {
        sum = 0u; cnt = 0u; mine = 0u;
#pragma unroll
        for (unsigned j = 0; j < 16; ++j) { const unsigned c = xb_ld(&bar[XB_XCNT(j)]); sum += c; cnt += (c > 0u) ? 1u : 0u; mine = (j == x) ? c : mine; }
        if (sum == G) break;
        __builtin_amdgcn_s_sleep(1);
        if ((++sp & 255u) == 0u) { if (xb_ld(&bar[XB_TMO])) break; if (sp > XB_SPIN_CAP) { atomicAdd(&bar[XB_TMO], 1u); break; } }
    }
    nloc = mine > 0u ? mine : 1u; nx = cnt > 0u ? cnt : 1u;
}
__device__ __forceinline__ void xcd_barrier(const XcdBarrier& b_) {
    XcdBarrier b = b_; b.x = xb_xcc_id();
    asm volatile("s_waitcnt vmcnt(0)" ::: "memory");
    __syncthreads();
    if (threadIdx.x == 0) {
        unsigned* bar = b.bar;
        __builtin_amdgcn_s_waitcnt(0);
        unsigned nloc = b.st[0], nx = b.st[1];
        if (nloc == 0u) { xcd_barrier_complete(bar, b.x, nloc, nx); b.st[0] = nloc; b.st[1] = nx; }
        const unsigned old = xb_add(&bar[XB_XSUB(b.x)], 1u);
        const unsigned gen = old / nloc;
        if (old + 1u == (gen + 1u) * nloc) {
            __builtin_amdgcn_fence(__ATOMIC_RELEASE, "agent");
            asm volatile("s_waitcnt vmcnt(0)" ::: "memory");
            const unsigned og = xb_add(&bar[XB_TOP], 1u);
            const unsigned tg = og / nx;
            if (og + 1u == (tg + 1u) * nx) xb_add(&bar[XB_TOPGEN], 1u);
            else XB_SPIN(xb_ld(&bar[XB_TOPGEN]) == tg, bar);
            __builtin_amdgcn_fence(__ATOMIC_ACQUIRE, "agent");
            xb_add(&bar[XB_XGEN(b.x)], 1u);
            asm volatile("s_waitcnt vmcnt(0)" ::: "memory");
        } else {
            XB_SPIN(xb_ld(&bar[XB_XGEN(b.x)]) == gen, bar);
            __builtin_amdgcn_fence(__ATOMIC_ACQUIRE, "agent");
            asm volatile("s_waitcnt vmcnt(0)" ::: "memory");
        }
    }
    __syncthreads();
}

namespace gm {
constexpr int BM = 256, BK = 64, HALF = 128, HTB = HALF * BK * 2, NXCD = 8, WGM = 8;
__host__ __device__ __forceinline__ int lds_byte(int r, int c) { const int st = (r >> 4) * 2 + (c >> 5), rr = r & 15, cc = c & 31, ob = rr * 64 + cc * 2; return st * 1024 + (ob ^ (((ob >> 9) & 1) << 5)); }
__host__ __device__ __forceinline__ void stage_rc(int b, int& R, int& C) { const int st = b / 1024, sb = b % 1024, swz = sb ^ (((sb >> 9) & 1) << 5); R = (st >> 1) * 16 + swz / 64; C = (st & 1) * 32 + (swz % 64) / 2; }
__host__ __device__ __forceinline__ int perm32(int rho) { const int n = rho >> 4, i = rho & 15; return 8 * (i >> 2) + 4 * n + (i & 3); }
struct Unit { int pm, pn; };
struct StaticOrder {
    int nM, nN, nwg, G, c;
    __device__ __forceinline__ void init(int nM_, int nN_, int G_, int c_) { nM = nM_; nN = nN_; nwg = nM * nN; G = G_; c = c_; }
    __device__ __forceinline__ bool next(int i, Unit& u) const {
        const long L = (long)i * G + c; if (L >= nwg) return false;
        int wgid = (int)L; { const int q = nwg / NXCD, r = nwg % NXCD, xcd = wgid % NXCD, off = wgid / NXCD; wgid = (xcd < r ? xcd * (q + 1) : r * (q + 1) + (xcd - r) * q) + off; }
        const int nig = WGM * nN, gid = wgid / nig, fm = gid * WGM, gsz = (nM - fm) < WGM ? (nM - fm) : WGM;
        u.pm = fm + ((wgid % nig) % gsz); u.pn = (wgid % nig) / gsz; return true;
    }
};
typedef f32x4 Acc[2][2][4][2];

template <class P>
__device__ __forceinline__ void gemm_phase(LAS unsigned char* lds, const P& p, int G, int cid, int tid) {
    constexpr bool GA = P::GA, GB = P::GB;
    const int wid = __builtin_amdgcn_readfirstlane(tid >> 6), lane = tid & 63, wr = wid >> 2, wc = wid & 3, fr = lane & 15, fq = lane >> 4;
    constexpr int K = P::K, nt = K / BK;
    static_assert(nt >= 2 && (nt % 2) == 0, "K must be a multiple of 128");
    unsigned vA[2], vB[2];
#pragma unroll
    for (int i = 0; i < 2; ++i) { int R, C; stage_rc(tid * 16 + i * 8192, R, C); const int Rb = (R & ~31) + perm32(R & 31); vA[i] = (unsigned)(R * P::ldA + C) * 2u; vB[i] = (unsigned)(Rb * P::ldB + C) * 2u; }
    constexpr size_t hsA = (size_t)HALF * P::ldA * 2, hsB = (size_t)HALF * P::ldB * 2;
    const unsigned ldsw = (unsigned)wid * 1024u;
    const int aoff = lds_byte(wr * 64 + fr, fq * 8), boff = lds_byte(wc * 32 + fr, fq * 8);
    unsigned gA[2][2], gB[2][2]; int preA[2][2];
#define G_GATHER_A(U, USEPRE) do { int _tz = threadIdx.x; asm volatile("" : "+v"(_tz)); _Pragma("unroll") for (int _i = 0; _i < 2; ++_i) { int _R, _C; stage_rc(_tz * 16 + _i * 8192, _R, _C); \
        _Pragma("unroll") for (int _h = 0; _h < 2; ++_h) { const int _row = (USEPRE) ? preA[_h][_i] : p.rowA(U, _h * HALF + _R); gA[_h][_i] = (unsigned)(_row * P::ldA + _C) * 2u; } } } while (0)
#define G_GATHER_B(U) do { int _tz = threadIdx.x; asm volatile("" : "+v"(_tz)); _Pragma("unroll") for (int _i = 0; _i < 2; ++_i) { int _R, _C; stage_rc(_tz * 16 + _i * 8192, _R, _C); const int _Rb = (_R & ~31) + perm32(_R & 31); \
        _Pragma("unroll") for (int _h = 0; _h < 2; ++_h) gB[_h][_i] = (unsigned)(p.rowB(U, _h * HALF + _Rb) * P::ldB + _C) * 2u; } } while (0)
#define G_PREF_A(U) do { int _tz = threadIdx.x; asm volatile("" : "+v"(_tz)); _Pragma("unroll") for (int _i = 0; _i < 2; ++_i) { int _R, _C; stage_rc(_tz * 16 + _i * 8192, _R, _C); \
        _Pragma("unroll") for (int _h = 0; _h < 2; ++_h) preA[_h][_i] = p.rowA(U, _h * HALF + _R); } } while (0)
#define G_SA(b, h) (((b) * 2 + (h)) * HTB)
#define G_SB(b, h) ((4 + (b) * 2 + (h)) * HTB)
#define G_GLDS(src, dstoff) __builtin_amdgcn_global_load_lds((const unsigned*)(src), (LAS unsigned*)(lds + (dstoff)), 16, 0, 0)
#define G_KT(kt) (P::KWRAP ? ((kt) >= P::KWRAP ? (kt) - P::KWRAP : (kt)) : (kt))
#define G_STAGE_A(bufoff, h, kt) do { const char* _b = GA ? (cA + (size_t)G_KT(kt) * 128) : (cA + (size_t)(h) * hsA + (size_t)G_KT(kt) * 128); \
        G_GLDS(_b + (GA ? gA[h][0] : vA[0]), (bufoff) + ldsw); G_GLDS(_b + (GA ? gA[h][1] : vA[1]), (bufoff) + ldsw + 8192); } while (0)
#define G_STAGE_B(bufoff, h, kt) do { const char* _b = GB ? (cB + (size_t)G_KT(kt) * 128) : (cB + (size_t)(h) * hsB + (size_t)G_KT(kt) * 128); \
        G_GLDS(_b + (GB ? gB[h][0] : vB[0]), (bufoff) + ldsw); G_GLDS(_b + (GB ? gB[h][1] : vB[1]), (bufoff) + ldsw + 8192); } while (0)
#define G_LDA(dst, b, h) do { _Pragma("unroll") for (int m = 0; m < 4; ++m) _Pragma("unroll") for (int k = 0; k < 2; ++k) dst[m][k] = *(const LAS bf16x8*)(lds + G_SA(b, h) + aoff + m * 2048 + k * 1024); } while (0)
#define G_LDB(dst, b, h) do { _Pragma("unroll") for (int n = 0; n < 2; ++n) _Pragma("unroll") for (int k = 0; k < 2; ++k) dst[n][k] = *(const LAS bf16x8*)(lds + G_SB(b, h) + boff + n * 2048 + k * 1024); } while (0)
#define G_CAT(x) __builtin_shufflevector(__builtin_bit_cast(v4i32, (x)[0]), __builtin_bit_cast(v4i32, (x)[1]), 0, 1, 2, 3, 4, 5, 6, 7)
#define G_MMA(ai, bj, At, Bt) do { __builtin_amdgcn_s_setprio(1); _Pragma("unroll") for (int m = 0; m < 4; ++m) _Pragma("unroll") for (int n = 0; n < 2; ++n) { \
        if constexpr (P::FP8) { acc[ai][bj][m][n] = __builtin_amdgcn_mfma_scale_f32_16x16x128_f8f6f4(G_CAT(Bt[n]), G_CAT(At[m]), acc[ai][bj][m][n], 0, 0, 0, P::SCALE_B, 0, P::SCALE_A); } \
        else { _Pragma("unroll") for (int k = 0; k < 2; ++k) acc[ai][bj][m][n] = __builtin_amdgcn_mfma_f32_16x16x32_bf16(Bt[n][k], At[m][k], acc[ai][bj][m][n], 0, 0, 0); } } \
        __builtin_amdgcn_s_setprio(0); } while (0)
#define G_WAIT_V(n) asm volatile("s_waitcnt vmcnt(" #n ")" ::: "memory")
#define G_WAIT_L(n) asm volatile("s_waitcnt lgkmcnt(" #n ")" ::: "memory")
#define G_BAR __builtin_amdgcn_s_barrier()
#define G_SCHED __builtin_amdgcn_sched_barrier(0)
    StaticOrder S; S.init(P::nM, P::nN, G, cid);
    Unit cur, nxt; int ui = 0;
    if (!S.next(0, cur)) return;
    Acc acc;
#pragma unroll
    for (int a = 0; a < 2; ++a)
#pragma unroll
        for (int b = 0; b < 2; ++b)
#pragma unroll
            for (int m = 0; m < 4; ++m)
#pragma unroll
                for (int n = 0; n < 2; ++n) acc[a][b][m][n] = (f32x4){0.f, 0.f, 0.f, 0.f};
    bf16x8 At[4][2], B0[2][2], B1[2][2];
    const char* cA = p.tileA(cur); const char* cB = p.tileB(cur);
    if constexpr (GA) { G_GATHER_A(cur, false); }
    if constexpr (GB) { G_GATHER_B(cur); }
    if constexpr (GA) { VM_WAIT(); }
    G_STAGE_B(G_SB(0, 0), 0, 0); G_STAGE_B(G_SB(0, 1), 1, 0); G_STAGE_A(G_SA(0, 0), 0, 0); G_STAGE_A(G_SA(0, 1), 1, 0);
    if (wr == 1) G_BAR;
    G_WAIT_V(2); G_BAR;
    G_STAGE_B(G_SB(1, 0), 0, 1); G_STAGE_A(G_SA(1, 0), 0, 1); G_STAGE_B(G_SB(1, 1), 1, 1);
    G_WAIT_V(6); G_BAR;
    for (;;) {
        const bool has_next = S.next(ui + 1, nxt);
        { size_t _z = 0; asm volatile("" : "+s"(_z)); cA += _z; cB += _z; }
        const char* nA = has_next ? p.tileA(nxt) : cA; const char* nB = has_next ? p.tileB(nxt) : cB;
        if constexpr (GA && P::PREFA) { if (has_next && nxt.pm != cur.pm) { G_PREF_A(nxt); asm volatile("" : "+v"(preA[0][0]), "+v"(preA[0][1]), "+v"(preA[1][0]), "+v"(preA[1][1])); } }
        int ntr = nt; asm volatile("" : "+s"(ntr));
#pragma nounroll
        for (int t = 0; t < ntr; t += 2) {
            const bool last = (t == ntr - 2);
            asm volatile("" : "+v"(vA[0]), "+v"(vA[1]), "+v"(vB[0]), "+v"(vB[1]));
            if constexpr (GA) asm volatile("" : "+v"(gA[0][0]), "+v"(gA[0][1]), "+v"(gA[1][0]), "+v"(gA[1][1]));
            if constexpr (GB) asm volatile("" : "+v"(gB[0][0]), "+v"(gB[0][1]), "+v"(gB[1][0]), "+v"(gB[1][1]));
            if constexpr (P::HOOK_KT > 0) { if (t == P::HOOK_KT) { int tz = threadIdx.x; asm volatile("" : "+v"(tz)); const int wid2 = tz >> 6, lane2 = tz & 63; p.hook(acc, cur, wid2 >> 2, wid2 & 3, lane2 & 15, lane2 >> 4); } }
            G_LDB(B0, 0, 0); G_LDB(B1, 0, 1); G_SCHED; G_LDA(At, 0, 0); G_STAGE_A(G_SA(1, 1), 1, t + 1);
            G_WAIT_V(8); G_WAIT_L(0); G_BAR; G_MMA(0, 0, At, B0); G_MMA(0, 1, At, B1); G_BAR; G_SCHED;
            int kb = t + 2;
            if (last) {
                kb = 0;
                if (has_next) {
                    cA = nA; cB = nB;
                    if constexpr (GA) { if (!P::PREFA || nxt.pm != cur.pm) G_GATHER_A(nxt, P::PREFA); }
                    if constexpr (GB) { G_GATHER_B(nxt); }
                }
            }
            G_LDA(At, 0, 1); G_STAGE_B(G_SB(0, 0), 0, kb); G_STAGE_B(G_SB(0, 1), 1, kb); G_STAGE_A(G_SA(0, 0), 0, kb);
            G_WAIT_V(8); G_WAIT_L(0); G_BAR; G_MMA(1, 0, At, B0); G_MMA(1, 1, At, B1); G_BAR; G_SCHED;
            G_LDB(B0, 1, 0); G_LDB(B1, 1, 1); G_SCHED; G_LDA(At, 1, 0); G_STAGE_A(G_SA(0, 1), 1, kb);
            G_WAIT_V(8); G_WAIT_L(0); G_BAR; G_MMA(0, 0, At, B0); G_MMA(0, 1, At, B1); G_BAR; G_SCHED;
            G_LDA(At, 1, 1); G_STAGE_B(G_SB(1, 0), 0, kb + 1); G_STAGE_B(G_SB(1, 1), 1, kb + 1); G_STAGE_A(G_SA(1, 0), 0, kb + 1);
            G_WAIT_V(8); G_WAIT_L(0); G_BAR; G_MMA(1, 0, At, B0); G_MMA(1, 1, At, B1); G_BAR; G_SCHED;
        }
        if (wr == 0) G_BAR;
        { int tz = threadIdx.x; asm volatile("" : "+v"(tz));
          const int wid2 = tz >> 6, lane2 = tz & 63; p.epi(acc, cur, wid2 >> 2, wid2 & 3, lane2 & 15, lane2 >> 4); }
        if (!has_next) break;
#pragma unroll
        for (int a = 0; a < 2; ++a)
#pragma unroll
            for (int b = 0; b < 2; ++b)
#pragma unroll
                for (int m = 0; m < 4; ++m)
#pragma unroll
                    for (int n = 0; n < 2; ++n) acc[a][b][m][n] = (f32x4){0.f, 0.f, 0.f, 0.f};
        cur = nxt; ++ui;
        if (wr == 1) G_BAR;
    }
    G_WAIT_V(0);
    G_BAR;
#undef G_GATHER_A
#undef G_GATHER_B
#undef G_PREF_A
#undef G_SA
#undef G_SB
#undef G_GLDS
#undef G_STAGE_A
#undef G_STAGE_B
#undef G_LDA
#undef G_LDB
#undef G_MMA
#undef G_CAT
#undef G_WAIT_V
#undef G_WAIT_L
#undef G_BAR
#undef G_SCHED
}
}
using gm::Unit; using gm::Acc;

struct PInM {
    static constexpr bool GA = false, GB = false, PREFA = false, FP8 = false; static constexpr int SCALE_A = 0, SCALE_B = 0, KWRAP = 0; static constexpr int HOOK_KT = 0, K = D, ldA = D, ldB = D, nM = T / 256, nN = 11;
    const bf16_t* A; const bf16_t* B; bf16_t *Q, *Kb, *VT, *GR, *GBt;
    __device__ __forceinline__ const char* tileA(const Unit& u) const { return (const char*)A + (size_t)u.pm * 256 * ldA * 2; }
    __device__ __forceinline__ const char* tileB(const Unit& u) const { return (const char*)B + (size_t)u.pn * 256 * ldB * 2; }
    __device__ __forceinline__ int rowA(const Unit&, int) const { return 0; }
    __device__ __forceinline__ int rowB(const Unit&, int) const { return 0; }
    __device__ __forceinline__ void hook(Acc&, const Unit&, int, int, int, int) const {}
    __device__ __forceinline__ void epi(const Acc& acc, const Unit& u, int wr, int wc, int fr, int fq) const {
        const int row0 = u.pm * 256 + wr * 64 + fr, cw = wc * 32 + 8 * fq;
        if (u.pn < 2) {
#pragma unroll
            for (int ai = 0; ai < 2; ++ai)
#pragma unroll
                for (int m = 0; m < 4; ++m) { bf16_t* rp = Q + (size_t)(row0 + ai * 128 + m * 16) * AW + u.pn * 256 + cw;
#pragma unroll
                    for (int bj = 0; bj < 2; ++bj) *(u32x4*)(rp + bj * 128) = pack8(acc[ai][bj][m][0], acc[ai][bj][m][1]); }
        } else if (u.pn == 2) {
#pragma unroll
            for (int ai = 0; ai < 2; ++ai)
#pragma unroll
                for (int m = 0; m < 4; ++m) { const int row = row0 + ai * 128 + m * 16;
                    *(u32x4*)(Kb + (size_t)row * KVW + cw) = pack8(acc[ai][0][m][0], acc[ai][0][m][1]);
                    const int b = row >> 14, s = row & (SEQ - 1);
#pragma unroll
                    for (int n = 0; n < 2; ++n)
#pragma unroll
                        for (int j = 0; j < 4; ++j) VT[(size_t)(b * KVW + cw + 4 * n + j) * SEQ + s] = (bf16_t)f2bf(acc[ai][1][m][n][j]); }
        } else {
            const int cc = (u.pn - 3) * 128 + cw;
#pragma unroll
            for (int ai = 0; ai < 2; ++ai)
#pragma unroll
                for (int m = 0; m < 4; ++m) { const size_t o = (size_t)(row0 + ai * 128 + m * 16) * D + cc; f32x4 r[2], s[2];
#pragma unroll
                    for (int n = 0; n < 2; ++n)
#pragma unroll
                        for (int j = 0; j < 4; ++j) { const float ta = 1.f + fexp2(fminf(-acc[ai][0][m][n][j], 100.f)), tb = 1.f + fexp2(fminf(-acc[ai][1][m][n][j], 100.f));
                            s[n][j] = frcp(tb); r[n][j] = tb * frcp(ta); }
                    *(u32x4*)(GR + o) = pack8(r[0], r[1]); *(u32x4*)(GBt + o) = pack8(s[0], s[1]); }
        }
    }
};
struct PInF {
    static constexpr bool GA = false, GB = true, PREFA = false, FP8 = false; static constexpr int SCALE_A = 0, SCALE_B = 0, KWRAP = 0; static constexpr int HOOK_KT = 0, K = D, ldA = D, ldB = D, nM = 2, nN = T / 256;
    const bf16_t* A; const bf16_t* B; bf16_t* FT;
    __device__ __forceinline__ const char* tileA(const Unit& u) const { return (const char*)A + (size_t)u.pm * 256 * ldA * 2; }
    __device__ __forceinline__ const char* tileB(const Unit&) const { return (const char*)B; }
    __device__ __forceinline__ int rowA(const Unit&, int) const { return 0; }
    __device__ __forceinline__ int rowB(const Unit& u, int c) const { const int np = u.pn * 256 + c, b = np >> 14, n2 = np & (SEQ - 1); return b * SEQ + (n2 & 127) * 128 + (n2 >> 7); }
    __device__ __forceinline__ void hook(Acc&, const Unit&, int, int, int, int) const {}
    __device__ __forceinline__ void epi(const Acc& acc, const Unit& u, int wr, int wc, int fr, int fq) const {
        const int ch0 = u.pm * 256 + wr * 64 + fr, b = u.pn >> 6, nc = (u.pn & 63) * 256 + wc * 32 + 8 * fq;
#pragma unroll
        for (int ai = 0; ai < 2; ++ai)
#pragma unroll
            for (int m = 0; m < 4; ++m) { bf16_t* rp = FT + (size_t)(b * FW + ch0 + ai * 128 + m * 16) * SEQ + nc;
#pragma unroll
                for (int bj = 0; bj < 2; ++bj) *(u32x4*)(rp + bj * 128) = pack8(acc[ai][bj][m][0], acc[ai][bj][m][1]); }
    }
};
struct PF1 {
    static constexpr bool GA = false, GB = false, PREFA = false, FP8 = false; static constexpr int SCALE_A = 0, SCALE_B = 0, KWRAP = 0; static constexpr int HOOK_KT = 0, K = 128, ldA = 128, ldB = 128, nM = 1, nN = BATCH * FW * 128 / 256;
    const bf16_t* A; const bf16_t* B; bf16_t* QP; const float* twc; const float* tws;
    __device__ __forceinline__ const char* tileA(const Unit&) const { return (const char*)A; }
    __device__ __forceinline__ const char* tileB(const Unit& u) const { return (const char*)B + (size_t)u.pn * 256 * ldB * 2; }
    __device__ __forceinline__ int rowA(const Unit&, int) const { return 0; }
    __device__ __forceinline__ int rowB(const Unit&, int) const { return 0; }
    __device__ __forceinline__ void hook(Acc&, const Unit&, int, int, int, int) const {}
    __device__ __forceinline__ void epi(const Acc& acc, const Unit& u, int wr, int wc, int fr, int fq) const {
        const int cw = wc * 32 + 8 * fq;
        f32x4 c[4][2], s[4][2];
#pragma unroll
        for (int m = 0; m < 4; ++m) { const int klo = wr * 64 + m * 16 + fr;
#pragma unroll
            for (int n = 0; n < 2; ++n) { c[m][n] = *(const f32x4*)(twc + klo * 128 + cw + 4 * n); s[m][n] = *(const f32x4*)(tws + klo * 128 + cw + 4 * n); } }
#pragma unroll
        for (int m = 0; m < 4; ++m) { const int klo = wr * 64 + m * 16 + fr;
#pragma unroll
            for (int bj = 0; bj < 2; ++bj) { f32x4 qr[2], qi[2];
#pragma unroll
                for (int n = 0; n < 2; ++n) { const f32x4 pr = acc[0][bj][m][n], pi = acc[1][bj][m][n]; qr[n] = pr * c[m][n] + pi * s[m][n]; qi[n] = pi * c[m][n] - pr * s[m][n]; }
                bf16_t* rp = QP + ((size_t)((u.pn * 2 + bj) * 128 + klo) * 2) * 128 + cw;
                *(u32x4*)(rp) = pack8(qr[0], qr[1]); *(u32x4*)(rp + 128) = pack8(qi[0], qi[1]); } }
    }
};
struct PF2 {
    static constexpr bool GA = false, GB = true, PREFA = false, FP8 = false; static constexpr int SCALE_A = 0, SCALE_B = 0, KWRAP = 0; static constexpr int HOOK_KT = 0, K = 256, ldA = 256, ldB = 256, nM = 1, nN = 512;
    const bf16_t* A; const bf16_t* B; bf16_t* AH;
    __device__ __forceinline__ const char* tileA(const Unit&) const { return (const char*)A; }
    __device__ __forceinline__ const char* tileB(const Unit&) const { return (const char*)B; }
    __device__ __forceinline__ int rowA(const Unit&, int) const { return 0; }
    __device__ __forceinline__ int rowB(const Unit& u, int c) const { const int b = u.pn >> 8, chq = (u.pn >> 6) & 3, klo = (u.pn & 63) * 2 + (c >> 7), ch = chq * 128 + (c & 127); return (b * FW + ch) * 128 + klo; }
    __device__ __forceinline__ void hook(Acc&, const Unit&, int, int, int, int) const {}
    __device__ __forceinline__ void epi(const Acc& acc, const Unit& u, int wr, int wc, int fr, int fq) const {
        const int b = u.pn >> 8, chq = (u.pn >> 6) & 3, klo0 = (u.pn & 63) * 2, ch = chq * 128 + wc * 32 + 8 * fq;
#pragma unroll
        for (int ai = 0; ai < 2; ++ai)
#pragma unroll
            for (int m = 0; m < 4; ++m) { const int khi = wr * 64 + m * 16 + fr;
#pragma unroll
                for (int bj = 0; bj < 2; ++bj) { const int tok = b * SEQ + 128 * khi + klo0 + bj;
                    *(u32x4*)(AH + (size_t)tok * AHW + 512 + ai * 512 + ch) = pack8(acc[ai][bj][m][0], acc[ai][bj][m][1]); } }
    }
};
struct PMg {
    static constexpr bool GA = false, GB = false, PREFA = false, FP8 = false; static constexpr int SCALE_A = 0, SCALE_B = 0, KWRAP = 0; static constexpr int HOOK_KT = 8, K = AHW, ldA = AHW, ldB = AHW, nM = T / 256, nN = 4;
    const bf16_t* A; const bf16_t* B; const bf16_t* GR; const bf16_t* GBt; bf16_t* MG;
    __device__ __forceinline__ const char* tileA(const Unit& u) const { return (const char*)A + (size_t)u.pm * 256 * ldA * 2; }
    __device__ __forceinline__ const char* tileB(const Unit& u) const { return (const char*)B + (size_t)u.pn * 256 * ldB * 2; }
    __device__ __forceinline__ int rowA(const Unit&, int) const { return 0; }
    __device__ __forceinline__ int rowB(const Unit&, int) const { return 0; }
    __device__ __forceinline__ void hook(Acc& acc, const Unit& u, int wr, int wc, int fr, int fq) const {
        const size_t o0 = (size_t)(u.pm * 256 + wr * 64 + fr) * D + u.pn * 256 + wc * 32 + 8 * fq;
        u32x4 w[2][4][2];
#pragma unroll
        for (int ai = 0; ai < 2; ++ai)
#pragma unroll
            for (int m = 0; m < 4; ++m)
#pragma unroll
                for (int bj = 0; bj < 2; ++bj) w[ai][m][bj] = *(const u32x4*)(GR + o0 + (size_t)(ai * 128 + m * 16) * D + bj * 128);
#pragma unroll
        for (int ai = 0; ai < 2; ++ai)
#pragma unroll
            for (int m = 0; m < 4; ++m)
#pragma unroll
                for (int bj = 0; bj < 2; ++bj) { f32x4 r0, r1; unpack8(w[ai][m][bj], r0, r1); acc[ai][bj][m][0] *= r0; acc[ai][bj][m][1] *= r1; }
    }
    __device__ __forceinline__ void epi(const Acc& acc, const Unit& u, int wr, int wc, int fr, int fq) const {
        const size_t o0 = (size_t)(u.pm * 256 + wr * 64 + fr) * D + u.pn * 256 + wc * 32 + 8 * fq;
        u32x4 w[2][4][2];
#pragma unroll
        for (int ai = 0; ai < 2; ++ai)
#pragma unroll
            for (int m = 0; m < 4; ++m)
#pragma unroll
                for (int bj = 0; bj < 2; ++bj) w[ai][m][bj] = *(const u32x4*)(GBt + o0 + (size_t)(ai * 128 + m * 16) * D + bj * 128);
#pragma unroll
        for (int ai = 0; ai < 2; ++ai)
#pragma unroll
            for (int m = 0; m < 4; ++m)
#pragma unroll
                for (int bj = 0; bj < 2; ++bj) { f32x4 s0, s1; unpack8(w[ai][m][bj], s0, s1);
                    *(u32x4*)(MG + o0 + (size_t)(ai * 128 + m * 16) * D + bj * 128) = pack8(acc[ai][bj][m][0] * s0, acc[ai][bj][m][1] * s1); }
    }
};
struct POut {
    static constexpr bool GA = false, GB = false, PREFA = false, FP8 = false; static constexpr int SCALE_A = 0, SCALE_B = 0, KWRAP = 0; static constexpr int HOOK_KT = 0, K = D, ldA = D, ldB = D, nM = T / 256, nN = 4;
    const bf16_t* A; const bf16_t* B; const float* xin32; bf16_t* xb;
    __device__ __forceinline__ const char* tileA(const Unit& u) const { return (const char*)A + (size_t)u.pm * 256 * ldA * 2; }
    __device__ __forceinline__ const char* tileB(const Unit& u) const { return (const char*)B + (size_t)u.pn * 256 * ldB * 2; }
    __device__ __forceinline__ int rowA(const Unit&, int) const { return 0; }
    __device__ __forceinline__ int rowB(const Unit&, int) const { return 0; }
    __device__ __forceinline__ void hook(Acc&, const Unit&, int, int, int, int) const {}
    __device__ __forceinline__ void epi(const Acc& acc, const Unit& u, int wr, int wc, int fr, int fq) const {
        const size_t o0 = (size_t)(u.pm * 256 + wr * 64 + fr) * D + u.pn * 256 + wc * 32 + 8 * fq;
        if (xin32) {
#pragma unroll
            for (int ai = 0; ai < 2; ++ai) {
                f32x4 xv[4][2][2];
#pragma unroll
                for (int m = 0; m < 4; ++m)
#pragma unroll
                    for (int bj = 0; bj < 2; ++bj) { const size_t o = o0 + (size_t)(ai * 128 + m * 16) * D + bj * 128; xv[m][bj][0] = *(const f32x4*)(xin32 + o); xv[m][bj][1] = *(const f32x4*)(xin32 + o + 4); }
#pragma unroll
                for (int m = 0; m < 4; ++m)
#pragma unroll
                    for (int bj = 0; bj < 2; ++bj) { const size_t o = o0 + (size_t)(ai * 128 + m * 16) * D + bj * 128;
                        *(u32x4*)(xb + o) = pack8(xv[m][bj][0] + acc[ai][bj][m][0], xv[m][bj][1] + acc[ai][bj][m][1]); }
                asm volatile("" ::: "memory");
            }
        } else {
            u32x4 w[2][4][2];
#pragma unroll
            for (int ai = 0; ai < 2; ++ai)
#pragma unroll
                for (int m = 0; m < 4; ++m)
#pragma unroll
                    for (int bj = 0; bj < 2; ++bj) w[ai][m][bj] = *(const u32x4*)(xb + o0 + (size_t)(ai * 128 + m * 16) * D + bj * 128);
#pragma unroll
            for (int ai = 0; ai < 2; ++ai)
#pragma unroll
                for (int m = 0; m < 4; ++m)
#pragma unroll
                    for (int bj = 0; bj < 2; ++bj) { f32x4 x0, x1; unpack8(w[ai][m][bj], x0, x1);
                        *(u32x4*)(xb + o0 + (size_t)(ai * 128 + m * 16) * D + bj * 128) = pack8(x0 + acc[ai][bj][m][0], x1 + acc[ai][bj][m][1]); }
        }
    }
};
constexpr int FK = FFN_FP8 ? 2 : 1;
__device__ __forceinline__ unsigned pk4_fp8(float a, float b, float c, float d) { int r = __builtin_amdgcn_cvt_pk_fp8_f32(a, b, 0, false); r = __builtin_amdgcn_cvt_pk_fp8_f32(c, d, r, true); return (unsigned)r; }
struct PUp {
    static constexpr bool GA = true, GB = false, PREFA = true, FP8 = FFN_FP8 != 0; static constexpr int SCALE_A = 0, SCALE_B = 0, KWRAP = 0;
    static constexpr int HOOK_KT = 0, K = D / FK, ldA = D / FK, ldB = D / FK, nM = NSLOT / 256, nN = 22;
    const bf16_t* A; const bf16_t* B; const int* seltok; bf16_t* ACT;
    __device__ __forceinline__ const char* tileA(const Unit&) const { return (const char*)A; }
    __device__ __forceinline__ const char* tileB(const Unit& u) const { return (const char*)B + (size_t)(u.pm >> 4) * (2 * DFF) * ldB * 2 + (size_t)u.pn * 256 * ldB * 2; }
    __device__ __forceinline__ int rowA(const Unit& u, int r) const { return seltok[u.pm * 256 + r]; }
    __device__ __forceinline__ int rowB(const Unit&, int) const { return 0; }
    __device__ __forceinline__ void hook(Acc&, const Unit&, int, int, int, int) const {}
    __device__ __forceinline__ void epi(const Acc& acc, const Unit& u, int wr, int wc, int fr, int fq) const {
        const int row0 = u.pm * 256 + wr * 64 + fr, cc = u.pn * 128 + wc * 32 + 8 * fq;
#pragma unroll
        for (int ai = 0; ai < 2; ++ai)
#pragma unroll
            for (int m = 0; m < 4; ++m) { f32x4 a[2];
#pragma unroll
                for (int n = 0; n < 2; ++n)
#pragma unroll
                    for (int j = 0; j < 4; ++j) { const float g = acc[ai][0][m][n][j], up = acc[ai][1][m][n][j];
                        if constexpr (FP8) a[n][j] = __builtin_amdgcn_fmed3f((g * up) * (frcp(1.f + fexp2(g * (-1.f / 64.f))) * (1.f / 4096.f)), -448.f, 448.f);
                        else a[n][j] = g * up * frcp(1.f + fexp2(fminf(-g * LOG2E, 80.f))); }
                if constexpr (FP8) { u32x2 w; w.x = pk4_fp8(a[0][0], a[0][1], a[0][2], a[0][3]); w.y = pk4_fp8(a[1][0], a[1][1], a[1][2], a[1][3]);
                    *(u32x2*)((unsigned char*)ACT + (size_t)(row0 + ai * 128 + m * 16) * DFF + cc) = w; }
                else *(u32x4*)(ACT + (size_t)(row0 + ai * 128 + m * 16) * DFF + cc) = pack8(a[0], a[1]); }
    }
};
struct PDn {
    static constexpr bool GA = false, GB = false, PREFA = false, FP8 = FFN_FP8 != 0; static constexpr int SCALE_A = 0, SCALE_B = 0, KWRAP = 0;
    static constexpr int HOOK_KT = 0, K = DFF / FK, ldA = DFF / FK, ldB = DFF / FK, nM = NSLOT / 256, nN = 4;
    const bf16_t* A; const bf16_t* B; const float* selgate; bf16_t* Y;
    __device__ __forceinline__ const char* tileA(const Unit& u) const { return (const char*)A + (size_t)u.pm * 256 * ldA * 2; }
    __device__ __forceinline__ const char* tileB(const Unit& u) const { return (const char*)B + (size_t)(u.pm >> 4) * D * ldB * 2 + (size_t)u.pn * 256 * ldB * 2; }
    __device__ __forceinline__ int rowA(const Unit&, int) const { return 0; }
    __device__ __forceinline__ int rowB(const Unit&, int) const { return 0; }
    __device__ __forceinline__ void hook(Acc&, const Unit&, int, int, int, int) const {}
    __device__ __forceinline__ void epi(const Acc& acc, const Unit& u, int wr, int wc, int fr, int fq) const {
        const int row0 = u.pm * 256 + wr * 64 + fr, cc = u.pn * 256 + wc * 32 + 8 * fq;
#pragma unroll
        for (int ai = 0; ai < 2; ++ai)
#pragma unroll
            for (int m = 0; m < 4; ++m) { const int row = row0 + ai * 128 + m * 16; const float g = selgate[row] * (FP8 ? (1.f / 256.f) : 1.f);
#pragma unroll
                for (int bj = 0; bj < 2; ++bj) *(u32x4*)(Y + (size_t)row * D + cc + bj * 128) = pack8(acc[ai][bj][m][0] * g, acc[ai][bj][m][1] * g); }
    }
};

struct Args { const float* in[14]; float* out; unsigned char* ws; int ph_lo, ph_hi, li, pad; };
struct Frame {
    LAS unsigned char* lds; volatile LAS unsigned* MISC; unsigned* ctl; unsigned char* ws;
    int tid, lane, wave, vcu, G, bid;
};
__device__ __forceinline__ bf16_t* wsb(const Frame& F, size_t off) { return (bf16_t*)(F.ws + off); }

__device__ __forceinline__ void tr_item(const float* src, int ldn, const float* rs, float cs, bf16_t* dptr, int ldd, int lane) {
#pragma unroll 1
    for (int pass = 0; pass < 2; ++pass) {
        f32x4 v[32];
        const float* sp = src + (size_t)(pass * 32) * ldn + 4 * lane;
#pragma unroll
        for (int r = 0; r < 32; ++r) v[r] = __builtin_nontemporal_load((const f32x4*)(sp + (size_t)r * ldn));
#pragma unroll
        for (int r = 0; r < 32; ++r) { const float sc = rs ? rs[pass * 32 + r] * cs : cs; v[r] = v[r] * sc; }
#pragma unroll
        for (int j = 0; j < 4; ++j)
#pragma unroll
            for (int c = 0; c < 4; ++c) { u32x4 w; w.x = cvt_pk_bf16(v[8 * c][j], v[8 * c + 1][j]); w.y = cvt_pk_bf16(v[8 * c + 2][j], v[8 * c + 3][j]); w.z = cvt_pk_bf16(v[8 * c + 4][j], v[8 * c + 5][j]); w.w = cvt_pk_bf16(v[8 * c + 6][j], v[8 * c + 7][j]);
                *(u32x4*)(dptr + (size_t)j * ldd + pass * 32 + 8 * c) = w; }
    }
}
__device__ __forceinline__ void tr_item8(const float* src, int ldn, const float* rs, float cs, unsigned char* dst0, int ldd, int hi_stride, int lane, LAS unsigned char* tile) {
#pragma unroll 1
    for (int pass = 0; pass < 2; ++pass) {
        f32x4 v[32];
        const float* sp = src + (size_t)(pass * 32) * ldn + 4 * lane;
#pragma unroll
        for (int r = 0; r < 32; ++r) v[r] = __builtin_nontemporal_load((const f32x4*)(sp + (size_t)r * ldn));
#pragma unroll
        for (int r = 0; r < 32; ++r) { const float sc = rs ? rs[pass * 32 + r] * cs : cs; v[r] = v[r] * sc; }
#pragma unroll
        for (int j = 0; j < 4; ++j)
#pragma unroll
            for (int c = 0; c < 2; ++c) { u32x4 w; w.x = pk4_fp8(v[16 * c][j], v[16 * c + 1][j], v[16 * c + 2][j], v[16 * c + 3][j]); w.y = pk4_fp8(v[16 * c + 4][j], v[16 * c + 5][j], v[16 * c + 6][j], v[16 * c + 7][j]);
                w.z = pk4_fp8(v[16 * c + 8][j], v[16 * c + 9][j], v[16 * c + 10][j], v[16 * c + 11][j]); w.w = pk4_fp8(v[16 * c + 12][j], v[16 * c + 13][j], v[16 * c + 14][j], v[16 * c + 15][j]);
                const int row = 4 * lane + j, ch = 2 * pass + c;
                *(LAS u32x4*)(tile + row * 64 + ((ch ^ (lane & 3)) << 4)) = w; }
    }
    LDS_WAIT(); asm volatile("" ::: "memory");
    int lz = lane; asm volatile("" : "+v"(lz));
#pragma unroll
    for (int i = 0; i < 16; ++i) { const int row = 16 * i + (lz >> 2), ch = lz & 3; const u32x4 w = *(const LAS u32x4*)(tile + row * 64 + ((ch ^ ((row >> 2) & 3)) << 4));
        *(u32x4*)(dst0 + (size_t)((row >> 7) * hi_stride + (row & 127)) * ldd + 16 * ch) = w; if ((i & 3) == 3) asm volatile("" ::: "memory"); }
    LDS_WAIT(); asm volatile("" ::: "memory");
}
constexpr int EI_G = NE * 16 * 11, EI_DN = NE * 44 * 4, EI_LAYER = 2 * EI_G + EI_DN;
__device__ __forceinline__ void expert_item(const Frame& F, const Args& a, int l, int r, int lane) {
    const float* g_ffn = a.in[8]; const float* w_eg = a.in[10]; const float* w_eu = a.in[11]; const float* w_ed = a.in[12];
    unsigned char* wl = F.ws + WS_W + (size_t)l * W_LAYER;
    if (r < 2 * EI_G) { const int isu = r >= EI_G; if (isu) r -= EI_G; const int e = r / (16 * 11), r2 = r - e * (16 * 11), kb = r2 / 11, nb = r2 - kb * 11, n = nb * 256 + 4 * lane, k0 = kb * 64;
        const float* src = (isu ? w_eu : w_eg) + ((size_t)(l * NE + e) * D + k0) * DFF + nb * 256;
        if (FFN_FP8) tr_item8(src, DFF, g_ffn + l * D + k0, isu ? 64.f * 4.f / LOG2E : 64.f * LOG2E, (unsigned char*)(wl + WO_GU) + ((size_t)e * (2 * DFF) + 512 * nb + 128 * isu) * D + k0, D, 256, lane, F.lds + F.wave * 16384);
        else tr_item(src, DFF, g_ffn + l * D + k0, 1.f, (bf16_t*)(wl + WO_GU) + ((size_t)e * (2 * DFF) + 256 * (n >> 7) + 128 * isu + (n & 127)) * D + k0, D, lane);
    } else { r -= 2 * EI_G; const int e = r / (44 * 4), r2 = r - e * (44 * 4), kb = r2 >> 2, nb = r2 & 3, n = nb * 256 + 4 * lane, k0 = kb * 64;
        if (FFN_FP8) tr_item8(w_ed + ((size_t)(l * NE + e) * DFF + k0) * D + nb * 256, D, nullptr, 64.f, (unsigned char*)(wl + WO_D) + ((size_t)e * D + nb * 256) * DFF + k0, DFF, 128, lane, F.lds + F.wave * 16384);
        else tr_item(w_ed + ((size_t)(l * NE + e) * DFF + k0) * D + nb * 256, D, nullptr, 1.f, (bf16_t*)(wl + WO_D) + ((size_t)e * D + n) * DFF + k0, DFF, lane); }
}
constexpr int CW_DONE = 8192;
__device__ __forceinline__ void seam_filler(const Frame& F, const Args& a, int k, int need) {
    const int per_layer = (EI_LAYER + F.G - 1) / F.G, total = DEPTH * per_layer;
    volatile LAS int* q = (volatile LAS int*)(F.MISC + 16);
    __syncthreads();
    const int q0 = q[0];
    __syncthreads();
    if (q0 >= total) return;
    if (threadIdx.x == 0) { const unsigned old = __hip_atomic_fetch_add(F.ctl + CW_DONE + 64 * k, 1u, __ATOMIC_RELAXED, __HIP_MEMORY_SCOPE_AGENT); q[1] = (old + 1u == (unsigned)F.G) ? 1 : 0; }
    __syncthreads();
    const int lane = F.lane;
    for (;;) {
        if (q[0] >= need && q[1]) break;
        int it = 0; if (lane == 0) it = __hip_atomic_fetch_add((LAS int*)(F.MISC + 16), 1, __ATOMIC_RELAXED, __HIP_MEMORY_SCOPE_WORKGROUP);
        it = __builtin_amdgcn_readfirstlane(it);
        if (it >= total) break;
        const int l = it / per_layer, loc = it - l * per_layer;
        if (F.vcu * per_layer + loc < EI_LAYER) expert_item(F, a, l, F.vcu * per_layer + loc, lane);
        if (F.wave == 0) { if (__builtin_amdgcn_readfirstlane((int)__hip_atomic_load(F.ctl + CW_DONE + 64 * k, __ATOMIC_RELAXED, __HIP_MEMORY_SCOPE_AGENT)) >= F.G && lane == 0) q[1] = 1; }
    }
}
__device__ __forceinline__ int expert_items_main(int G) { const int total = DEPTH * EI_LAYER, ngw = G * NWAVES, rem = total % ngw; return ((G - BATCH * NE) * NWAVES >= rem && total - rem >= EI_LAYER) ? total - rem : total; }
__device__ __forceinline__ void p0_prologue(const Frame& F, const Args& a) {
    LAS float* cs128 = (LAS float*)(F.lds + RING_BYTES + 4096);
    if (F.tid < 128) { cs128[F.tid] = cospif((float)F.tid / 64.f); cs128[128 + F.tid] = sinpif((float)F.tid / 64.f); }
    __syncthreads();
    const int gw = F.vcu * NWAVES + F.wave, NGW = F.G * NWAVES, lane = F.lane;
    const float* w_in = a.in[3]; const float* g_mix = a.in[2]; const float* w_ap = a.in[5]; const float* w_fp = a.in[6]; const float* w_out = a.in[7];
    const float* g_ffn = a.in[8]; const float* w_router = a.in[9];
    constexpr int I_IN = 16 * 13, I_AP = 8 * 4, I_OUT = 16 * 4;
    constexpr int I_LAYER = I_IN + I_AP + I_OUT;
    for (int it = gw; it < DEPTH * I_LAYER; it += NGW) {
        const int l = it / I_LAYER; int r = it - l * I_LAYER;
        unsigned char* wl = F.ws + WS_W + (size_t)l * W_LAYER;
        if (r < I_IN) { const int kb = r / 13, nb = r - kb * 13, n = nb * 256 + 4 * lane, k0 = kb * 64; bf16_t* dp; float cs = 1.f;
            if (n < 768) { dp = (bf16_t*)(wl + WO_INM) + (size_t)n * D; if (n < 512) cs = 0.125f * LOG2E; }
            else if (n < 1280) dp = (bf16_t*)(wl + WO_F) + (size_t)(n - 768) * D;
            else { const int isb = n >= 2304, c = n - (isb ? 2304 : 1280); dp = (bf16_t*)(wl + WO_INM) + (size_t)(768 + 256 * (c >> 7) + 128 * isb + (c & 127)) * D; cs = LOG2E; }
            tr_item(w_in + (size_t)l * D * INW + (size_t)k0 * INW + nb * 256, INW, g_mix + l * D + k0, cs, dp + k0, D, lane); continue; }
        r -= I_IN;
        if (r < I_AP) { const int kb = r >> 2, nb = r & 3, n = nb * 256 + 4 * lane, k0 = kb * 64;
            tr_item(w_ap + (size_t)l * AW * D + (size_t)k0 * D + nb * 256, D, nullptr, 1.f, (bf16_t*)(wl + WO_MG) + (size_t)n * AHW + k0, AHW, lane); continue; }
        r -= I_AP;
        { const int kb = r >> 2, nb = r & 3, n = nb * 256 + 4 * lane, k0 = kb * 64;
            tr_item(w_out + (size_t)l * D * D + (size_t)k0 * D + nb * 256, D, nullptr, 1.f, (bf16_t*)(wl + WO_OUT) + (size_t)n * D + k0, D, lane); }
    }
    if (MK_N_LAUNCHES != 1 || !USE_FILLER) { const int nmain = expert_items_main(F.G); for (int it = gw; it < nmain; it += NGW) expert_item(F, a, it / EI_LAYER, it % EI_LAYER, lane); }
    for (int it = gw; it < DEPTH * 4 * 16 * 16; it += NGW) {
        const int l = it >> 10, g = (it >> 8) & 3, n2b = (it >> 4) & 15, nb = it & 15, n = nb * 64 + lane, n20 = n2b * 8;
        const float* wp = w_fp + (size_t)l * FW * D + (size_t)(g * 128) * D + n;
        float ac[8], as[8];
#pragma unroll
        for (int i = 0; i < 8; ++i) { ac[i] = 0.f; as[i] = 0.f; }
#pragma unroll 1
        for (int kh = 0; kh < 128; kh += 32) { float wv[32];
#pragma unroll
            for (int q = 0; q < 32; ++q) wv[q] = wp[(size_t)(kh + q) * D];
#pragma unroll
            for (int q = 0; q < 32; ++q) { const int k2 = kh + q;
#pragma unroll
                for (int i = 0; i < 8; ++i) { const int idx = (k2 * (n20 + i)) & 127; ac[i] += cs128[idx] * wv[q]; as[i] += cs128[128 + idx] * wv[q]; } } }
        const float isq = 0.08838834764831845f;
        bf16_t* dst = (bf16_t*)(F.ws + WS_W + (size_t)l * W_LAYER + WO_MG) + (size_t)n * AHW + 512 + g * 128 + n20;
        u32x4 oc, os; oc.x = pk2(ac[0] * isq, ac[1] * isq); oc.y = pk2(ac[2] * isq, ac[3] * isq); oc.z = pk2(ac[4] * isq, ac[5] * isq); oc.w = pk2(ac[6] * isq, ac[7] * isq);
        os.x = pk2(as[0] * isq, as[1] * isq); os.y = pk2(as[2] * isq, as[3] * isq); os.z = pk2(as[4] * isq, as[5] * isq); os.w = pk2(as[6] * isq, as[7] * isq);
        *(u32x4*)dst = oc; *(u32x4*)(dst + 512) = os;
    }
    const int gt = (F.vcu * NTHR + F.tid), NGT = F.G * NTHR; const float isq = 0.08838834764831845f;
    bf16_t* F1 = wsb(F, WS_F1); bf16_t* G2 = wsb(F, WS_G2); float* twc = (float*)(F.ws + WS_TWC); float* tws = (float*)(F.ws + WS_TWS); float* wrt = (float*)(F.ws + WS_WRT);
    for (int i = gt; i < 256 * 128; i += NGT) { const int m = i >> 7, k = i & 127, idx = ((m & 127) * k) & 127; const float v = (m < 128) ? cospif((float)idx / 64.f) : -sinpif((float)idx / 64.f); F1[i] = (bf16_t)f2bf(v * isq); }
    for (int i = gt; i < 256 * 256; i += NGT) { const int m = i >> 8, k = i & 255, ro = m >> 7, ri = k >> 7, idx = ((m & 127) * (k & 127)) & 127; const float c = cospif((float)idx / 64.f), s = sinpif((float)idx / 64.f);
        const float v = (ro == ri) ? c : (ro == 0 ? s : -s); G2[i] = (bf16_t)f2bf(v * isq); }
    for (int i = gt; i < 128 * 128; i += NGT) { const int klo = i >> 7, nlo = i & 127; const float ang = (float)(klo * nlo) / 8192.f; twc[i] = cospif(ang); tws[i] = sinpif(ang); }
    for (int i = gt; i < DEPTH * NE * D; i += NGT) { const int l = i / (NE * D), e = (i / D) % NE, d = i % D; wrt[i] = g_ffn[l * D + d] * w_router[((size_t)l * D + d) * NE + e]; }
}

template <bool SRC32> __device__ __forceinline__ void rp1_load(f32x4 (&d)[4], const float* xsrc32, const bf16_t* xb, int row, int lane) {
    if constexpr (SRC32) {
#pragma unroll
        for (int j = 0; j < 4; ++j) d[j] = *(const f32x4*)(xsrc32 + (size_t)row * D + 4 * lane + 256 * j);
    } else {
#pragma unroll
        for (int j = 0; j < 4; ++j) { const u32x2 w = *(const u32x2*)(xb + (size_t)row * D + 4 * lane + 256 * j); d[j][0] = bflo(w.x); d[j][1] = bfhi(w.x); d[j][2] = bflo(w.y); d[j][3] = bfhi(w.y); }
    }
}
template <bool COMBINE, bool STORE_X, bool FINAL, bool SRC32>
__device__ __forceinline__ void rp1(const Frame& F, const float* xsrc32, float* out32, bf16_t* h, const float* gfin) {
    const int gw = F.vcu * NWAVES + F.wave, NGW = F.G * NWAVES, lane = F.lane;
    const int* slot = (const int*)(F.ws + WS_SLOT); const bf16_t* Y = wsb(F, WS_Y); bf16_t* xb = wsb(F, WS_XB);
    constexpr int R = COMBINE ? 2 : 4;
    int m = gw; f32x4 v[R][4]; int sl[R];
#pragma unroll
    for (int r = 0; r < R; ++r) { sl[r] = -1; if (m + r * NGW < T) { rp1_load<SRC32>(v[r], xsrc32, xb, m + r * NGW, lane); if (COMBINE && lane < NE) sl[r] = slot[(m + r * NGW) * NE + lane]; } }
    for (; m < T; m += R * NGW) {
        const int mn = m + R * NGW; f32x4 nv[R][4]; int nsl[R];
#pragma unroll
        for (int r = 0; r < R; ++r) { nsl[r] = -1; if (mn + r * NGW < T) { rp1_load<SRC32>(nv[r], xsrc32, xb, mn + r * NGW, lane); if (COMBINE && lane < NE) nsl[r] = slot[(mn + r * NGW) * NE + lane]; } }
        if constexpr (COMBINE) {
            unsigned mk[R];
#pragma unroll
            for (int r = 0; r < R; ++r) mk[r] = (unsigned)__ballot(sl[r] >= 0);
            while (mk[0] | mk[R - 1]) {
                u32x2 y[R][2][4]; bool has[R][2];
#pragma unroll
                for (int r = 0; r < R; ++r)
#pragma unroll
                    for (int t = 0; t < 2; ++t) { has[r][t] = mk[r] != 0;
                        if (has[r][t]) { const int e = __builtin_ctz(mk[r]); mk[r] &= mk[r] - 1; const int sr = __builtin_amdgcn_readlane(sl[r], e);
#pragma unroll
                            for (int j = 0; j < 4; ++j) y[r][t][j] = *(const u32x2*)(Y + (size_t)sr * D + 4 * lane + 256 * j); } }
#pragma unroll
                for (int r = 0; r < R; ++r)
#pragma unroll
                    for (int t = 0; t < 2; ++t) if (has[r][t]) {
#pragma unroll
                        for (int j = 0; j < 4; ++j) { v[r][j][0] += bflo(y[r][t][j].x); v[r][j][1] += bfhi(y[r][t][j].x); v[r][j][2] += bflo(y[r][t][j].y); v[r][j][3] += bfhi(y[r][t][j].y); } }
            }
        }
#pragma unroll
        for (int r = 0; r < R; ++r) {
            const int mr = m + r * NGW;
            float ss = 0.f;
#pragma unroll
            for (int j = 0; j < 4; ++j) ss += (v[r][j][0] * v[r][j][0] + v[r][j][1] * v[r][j][1]) + (v[r][j][2] * v[r][j][2] + v[r][j][3] * v[r][j][3]);
            const float rstd = 1.0f / sqrtf(wave_sum(ss) * (1.f / D) + EPS);
            if (mr < T) {
                if constexpr (FINAL) {
#pragma unroll
                    for (int j = 0; j < 4; ++j) { const f32x4 g = *(const f32x4*)(gfin + 4 * lane + 256 * j); *(f32x4*)(out32 + (size_t)mr * D + 4 * lane + 256 * j) = v[r][j] * rstd * g; }
                } else {
                    if constexpr (STORE_X) {
#pragma unroll
                        for (int j = 0; j < 4; ++j) { u32x2 w; w.x = cvt_pk_bf16(v[r][j][0], v[r][j][1]); w.y = cvt_pk_bf16(v[r][j][2], v[r][j][3]); *(u32x2*)(xb + (size_t)mr * D + 4 * lane + 256 * j) = w; }
                    }
#pragma unroll
                    for (int j = 0; j < 4; ++j) { u32x2 w; w.x = cvt_pk_bf16(v[r][j][0] * rstd, v[r][j][1] * rstd); w.y = cvt_pk_bf16(v[r][j][2] * rstd, v[r][j][3] * rstd); *(u32x2*)(h + (size_t)mr * D + 4 * lane + 256 * j) = w; }
                }
            }
        }
#pragma unroll
        for (int r = 0; r < R; ++r) { sl[r] = nsl[r];
#pragma unroll
            for (int j = 0; j < 4; ++j) v[r][j] = nv[r][j]; }
    }
}
constexpr int RW_PITCH = D + 8;
__device__ __forceinline__ void rp2_mfma(const Frame& F, bf16_t* h, int layer) {
    const int lane = F.lane, r = lane & 15, g = lane >> 4;
    LAS bf16_t* whi = (LAS bf16_t*)F.lds; LAS bf16_t* wlo = whi + NE * RW_PITCH;
    const float* wrt = (const float*)(F.ws + WS_WRT) + (size_t)layer * NE * D;
    for (int i = F.tid; i < NE * D; i += NTHR) { const float w = wrt[i]; const unsigned hb = f2bf(w); const float hf = __builtin_bit_cast(float, hb << 16); const int e = i >> 10, k = i & (D - 1);
        whi[e * RW_PITCH + k] = (bf16_t)hb; wlo[e * RW_PITCH + k] = (bf16_t)f2bf(w - hf); }
    __syncthreads();
    const bf16_t* xb = wsb(F, WS_XB); float* aff = (float*)(F.ws + WS_AFF); int* slot = (int*)(F.ws + WS_SLOT);
    const int nblk = T / 16, gw = F.vcu * NWAVES + F.wave, NGW = F.G * NWAVES;
    for (int blk = gw; blk < nblk; blk += NGW) {
        const int row0 = blk * 16;
        bf16x8 xa[32];
        const bf16_t* xp = xb + (size_t)(row0 + r) * D + 8 * g; unsigned char* hp = (unsigned char*)h + (size_t)(row0 + r) * D + 8 * g;
#pragma unroll
        for (int ks = 0; ks < 32; ++ks) xa[ks] = *(const bf16x8*)(xp + 32 * ks);
        f32x4 acc = (f32x4){0.f, 0.f, 0.f, 0.f}; float ss = 0.f; const LAS bf16_t* wfh = whi + r * RW_PITCH + 8 * g;
#pragma unroll
        for (int ks = 0; ks < 32; ++ks) {
            const bf16x8 bh = *(const LAS bf16x8*)(wfh + 32 * ks), bl = *(const LAS bf16x8*)(wfh + NE * RW_PITCH + 32 * ks);
            acc = __builtin_amdgcn_mfma_f32_16x16x32_bf16(xa[ks], bh, acc, 0, 0, 0);
            acc = __builtin_amdgcn_mfma_f32_16x16x32_bf16(xa[ks], bl, acc, 0, 0, 0);
            const u32x4 w = __builtin_bit_cast(u32x4, xa[ks]);
            const float x0 = bflo(w.x), x1 = bfhi(w.x), x2 = bflo(w.y), x3 = bfhi(w.y), x4 = bflo(w.z), x5 = bfhi(w.z), x6 = bflo(w.w), x7 = bfhi(w.w);
            ss += ((x0 * x0 + x1 * x1) + (x2 * x2 + x3 * x3)) + ((x4 * x4 + x5 * x5) + (x6 * x6 + x7 * x7));
            if ((ks & 3) == 3) asm volatile("" : "+v"(acc), "+v"(ss) :: "memory");
        }
        ss = x16_sum(ss); ss = x32_sum(ss);
        const float rstd = 1.0f / sqrtf(ss * (1.f / D) + EPS);
#pragma unroll
        for (int ks = 0; ks < 32; ++ks) { u32x4 w = __builtin_bit_cast(u32x4, xa[ks]); asm volatile("" : "+v"(w)); u32x2 o;
            o.x = pk4_fp8(bflo(w.x) * rstd, bfhi(w.x) * rstd, bflo(w.y) * rstd, bfhi(w.y) * rstd); o.y = pk4_fp8(bflo(w.z) * rstd, bfhi(w.z) * rstd, bflo(w.w) * rstd, bfhi(w.w) * rstd);
            *(u32x2*)(hp + 32 * ks) = o; if ((ks & 3) == 3) asm volatile("" ::: "memory"); }
#pragma unroll
        for (int reg = 0; reg < 4; ++reg) {
            const float rs = __builtin_bit_cast(float, __builtin_amdgcn_ds_bpermute((4 * g + reg) << 2, __builtin_bit_cast(int, rstd)));
            const float lg = acc[reg] * rs;
            float mx = lg; mx = fmaxf(mx, dpp_mov<0xB1>(mx)); mx = fmaxf(mx, dpp_mov<0x4E>(mx)); mx = fmaxf(mx, dpp_mov<0x141>(mx)); mx = fmaxf(mx, dpp_mov<0x140>(mx));
            const float ex = expf(lg - mx); float den = ex; den += dpp_mov<0xB1>(den); den += dpp_mov<0x4E>(den); den += dpp_mov<0x141>(den); den += dpp_mov<0x140>(den);
            const int mr = row0 + 4 * g + reg, b = mr >> 14, sq = mr & (SEQ - 1);
            aff[(size_t)(b * NE + r) * SEQ + sq] = ex / den; slot[mr * NE + r] = -1;
        }
    }
    __syncthreads();
}
__device__ __forceinline__ void rp2(const Frame& F, bf16_t* h, int layer) {
    const bf16_t* xb = wsb(F, WS_XB);
    const int gw = F.vcu * NWAVES + F.wave, NGW = F.G * NWAVES, lane = F.lane;
    LAS float* wl = (LAS float*)F.lds;
    const float* wrt = (const float*)(F.ws + WS_WRT) + (size_t)layer * NE * D;
    for (int i = F.tid; i < NE * D / 4; i += NTHR) ((LAS f32x4*)wl)[i] = ((const f32x4*)wrt)[i];
    __syncthreads();
    float* aff = (float*)(F.ws + WS_AFF); int* slot = (int*)(F.ws + WS_SLOT);
    constexpr int R = 2;
    int m = gw; f32x4 v[R][4];
#pragma unroll
    for (int r = 0; r < R; ++r) if (m + r * NGW < T) {
        rp1_load<false>(v[r], nullptr, xb, m + r * NGW, lane);
    }
    for (; m < T; m += R * NGW) {
        const int mn = m + R * NGW; f32x4 nv[R][4];
#pragma unroll
        for (int r = 0; r < R; ++r) if (mn + r * NGW < T) rp1_load<false>(nv[r], nullptr, xb, mn + r * NGW, lane);
        float rstd[R];
#pragma unroll
        for (int r = 0; r < R; ++r) { float ss = 0.f;
#pragma unroll
            for (int j = 0; j < 4; ++j) ss += (v[r][j][0] * v[r][j][0] + v[r][j][1] * v[r][j][1]) + (v[r][j][2] * v[r][j][2] + v[r][j][3] * v[r][j][3]);
            rstd[r] = 1.0f / sqrtf(wave_sum(ss) * (1.f / D) + EPS); }
#pragma unroll
        for (int r = 0; r < R; ++r) if (m + r * NGW < T) {
#pragma unroll
            for (int j = 0; j < 4; ++j) { const size_t o = (size_t)(m + r * NGW) * D + 4 * lane + 256 * j;
                if (FFN_FP8) *(unsigned*)((unsigned char*)h + o) = pk4_fp8(v[r][j][0] * rstd[r], v[r][j][1] * rstd[r], v[r][j][2] * rstd[r], v[r][j][3] * rstd[r]);
                else { u32x2 w; w.x = cvt_pk_bf16(v[r][j][0] * rstd[r], v[r][j][1] * rstd[r]); w.y = cvt_pk_bf16(v[r][j][2] * rstd[r], v[r][j][3] * rstd[r]); *(u32x2*)(h + o) = w; } }
        }
        float pr[R][NE];
        f32x4 wc[4], wn[4];
#pragma unroll
        for (int j = 0; j < 4; ++j) wc[j] = *(const LAS f32x4*)(wl + 4 * lane + 256 * j);
#pragma unroll
        for (int e = 0; e < NE; ++e) {
            if (e + 1 < NE) {
#pragma unroll
                for (int j = 0; j < 4; ++j) wn[j] = *(const LAS f32x4*)(wl + (e + 1) * D + 4 * lane + 256 * j);
            }
            asm volatile("" ::: "memory");
#pragma unroll
            for (int r = 0; r < R; ++r) { float sacc = 0.f;
#pragma unroll
                for (int j = 0; j < 4; ++j) sacc += (v[r][j][0] * wc[j][0] + v[r][j][1] * wc[j][1]) + (v[r][j][2] * wc[j][2] + v[r][j][3] * wc[j][3]);
                pr[r][e] = sacc; }
            asm volatile("" : "+v"(pr[0][e]), "+v"(pr[1][e]) :: "memory");
#pragma unroll
            for (int j = 0; j < 4; ++j) wc[j] = wn[j];
        }
#pragma unroll
        for (int r = 0; r < R; ++r) {
            float p8[8], p4[4], p2[2], p1;
            { const bool up = (lane & 32) != 0;
#pragma unroll
              for (int i = 0; i < 8; ++i) { const float keep = up ? pr[r][8 + i] : pr[r][i], send = up ? pr[r][i] : pr[r][8 + i]; p8[i] = keep + x32_get(send, up); } }
            { const bool up = (lane & 16) != 0;
#pragma unroll
              for (int i = 0; i < 4; ++i) { const float keep = up ? p8[4 + i] : p8[i], send = up ? p8[i] : p8[4 + i]; p4[i] = keep + x16_get(send, up); } }
            { const bool up = (lane & 8) != 0;
#pragma unroll
              for (int i = 0; i < 2; ++i) { const float keep = up ? p4[2 + i] : p4[i], send = up ? p4[i] : p4[2 + i]; p2[i] = keep + swz_xor<8>(send); } }
            { const bool up = (lane & 4) != 0; const float keep = up ? p2[1] : p2[0], send = up ? p2[0] : p2[1]; p1 = keep + swz_xor<4>(send); }
            p1 += swz_xor<2>(p1); p1 += swz_xor<1>(p1);
            const float lg = p1 * rstd[r]; const int ex_e = ((lane >> 5) & 1) * 8 + ((lane >> 4) & 1) * 4 + ((lane >> 3) & 1) * 2 + ((lane >> 2) & 1);
            float mx = lg; mx = fmaxf(mx, swz_xor<4>(mx)); mx = fmaxf(mx, swz_xor<8>(mx)); mx = x16_max(mx); mx = x32_max(mx);
            const float ex = expf(lg - mx); float den = ex; den += swz_xor<4>(den); den += swz_xor<8>(den); den = x16_sum(den); den = x32_sum(den);
            const int mr = m + r * NGW;
            if ((lane & 3) == 0 && mr < T) { const int b = mr >> 14, sq = mr & (SEQ - 1); aff[(size_t)(b * NE + ex_e) * SEQ + sq] = ex / den; slot[mr * NE + ex_e] = -1; }
        }
#pragma unroll
        for (int r = 0; r < R; ++r)
#pragma unroll
            for (int j = 0; j < 4; ++j) v[r][j] = nv[r][j];
    }
    __syncthreads();
}
__device__ __forceinline__ void topk_phase(const Frame& F, const Args& args_, int layer) {
    if (F.bid >= BATCH * NE) {
        if (layer == 0) { const int it = expert_items_main(F.G) + (F.bid - BATCH * NE) * NWAVES + F.wave; if (it < DEPTH * EI_LAYER) expert_item(F, args_, it / EI_LAYER, it % EI_LAYER, F.lane); }
        return;
    }
    const int e = F.bid >> 1, b = F.bid & 1, tid = F.tid, lane = F.lane, wave = F.wave;
    const unsigned* a = (const unsigned*)(F.ws + WS_AFF) + (size_t)(b * NE + e) * SEQ;
    LAS int* red = (LAS int*)F.lds;
    unsigned v[32];
#pragma unroll
    for (int j = 0; j < 8; ++j) { const u32x4 w = *(const u32x4*)(a + 32 * tid + 4 * j); v[4 * j] = w.x; v[4 * j + 1] = w.y; v[4 * j + 2] = w.z; v[4 * j + 3] = w.w; }
    unsigned Tv = 0u; int it = 0;
    for (int bit = 30; bit >= 0; --bit, ++it) {
        const unsigned cand = Tv | (1u << bit); int c = 0;
#pragma unroll
        for (int j = 0; j < 32; ++j) c += (v[j] >= cand) ? 1 : 0;
        c = wave_sum_i(c);
        LAS int* slot = red + (it & 1) * 8;
        if (lane == 0) slot[wave] = c;
        __syncthreads();
        int tot = 0;
#pragma unroll
        for (int w = 0; w < 8; ++w) tot += slot[w];
        if (tot >= CAP) Tv = cand;
    }
    __syncthreads();
    int cg = 0, ce = 0;
#pragma unroll
    for (int j = 0; j < 32; ++j) { cg += (v[j] > Tv) ? 1 : 0; ce += (v[j] == Tv) ? 1 : 0; }
    int sg = cg, se = ce;
#pragma unroll
    for (int o = 1; o < 64; o <<= 1) { const int src = ((lane >= o ? lane - o : lane) << 2); const int tg = __builtin_amdgcn_ds_bpermute(src, sg), te = __builtin_amdgcn_ds_bpermute(src, se); if (lane >= o) { sg += tg; se += te; } }
    LAS int* wtot = red + 16;
    if (lane == 63) { wtot[wave] = sg; wtot[8 + wave] = se; }
    __syncthreads();
    int bg = 0, be = 0, totg = 0;
#pragma unroll
    for (int w = 0; w < 8; ++w) { const int xg = wtot[w], xe = wtot[8 + w]; if (w < wave) { bg += xg; be += xe; } totg += xg; }
    int pg = bg + sg - cg, pe = be + se - ce;
    const int need = CAP - totg;
    const int slotbase = (e * BATCH + b) * CAP;
    int* seltok = (int*)(F.ws + WS_SELTOK); float* selgate = (float*)(F.ws + WS_SELGATE); int* slot = (int*)(F.ws + WS_SLOT);
#pragma unroll
    for (int j = 0; j < 32; ++j) {
        const bool isg = v[j] > Tv, ise = v[j] == Tv;
        const bool sel = isg || (ise && pe < need);
        if (sel) { const int pos = slotbase + pg + (pe < need ? pe : need); const int tok = b * SEQ + 32 * tid + j;
            seltok[pos] = tok; selgate[pos] = __builtin_bit_cast(float, v[j]); slot[tok * NE + e] = pos; }
        pg += isg ? 1 : 0; pe += ise ? 1 : 0;
    }
}

constexpr int AT_K = 0, AT_VT = 49152, AT_VPITCH = 776, AT_TAB = AT_VT + 64 * AT_VPITCH, AT_END = AT_TAB + 4 * 512 * 4;
static_assert(AT_END <= RING_BYTES && (AT_TAB % 16) == 0, "attention LDS");
__device__ __forceinline__ int crow(int r, int hi) { return (r & 3) + 8 * (r >> 2) + 4 * hi; }
__device__ __forceinline__ int t5_bucket(int rel) {
    const int n = rel < 0 ? -rel : rel; const int ret = rel > 0 ? 16 : 0;
    if (n < 8) return ret + n;
    int lg = 8 + (n >= 12) + (n >= 16) + (n >= 23) + (n >= 32) + (n >= 46) + (n >= 64) + (n >= 91);
    return ret + lg;
}
__device__ __forceinline__ void attn_phase(const Frame& F, const bf16_t* Q, const bf16_t* Kb, const bf16_t* VT, bf16_t* AH, const float* rel_bias, const float* sink) {
    LAS unsigned char* lds = F.lds; const int tid = F.tid, lane = F.lane, wave = F.wave;
    LAS float* TAB = (LAS float*)(lds + AT_TAB);
    for (int ui = F.bid; ui < BATCH * 128 * 2; ui += F.G) {
        const int kvh = ui & 1, nb = (ui >> 1) & 127, b = ui >> 8;
        const int s0 = 128 * nb - 128;
        __syncthreads();
#pragma unroll
        for (int i = 0; i < 6; ++i) { const int id = tid + 512 * i, row = id >> 3, ch = id & 7, s = s0 + row;
            u32x4 w = (u32x4){0u, 0u, 0u, 0u}; if (s >= 0 && s < SEQ) w = *(const u32x4*)(Kb + (size_t)(b * SEQ + s) * KVW + kvh * 64 + ch * 8);
            *(LAS u32x4*)(lds + AT_K + row * 128 + ((ch ^ (row & 7)) << 4)) = w; }
#pragma unroll
        for (int i = 0; i < 6; ++i) { const int id = tid + 512 * i, d = id / 48, ch = id - d * 48, s = s0 + 8 * ch;
            u32x4 w = (u32x4){0u, 0u, 0u, 0u}; if (s >= 0 && s < SEQ) w = *(const u32x4*)(VT + (size_t)(b * KVW + kvh * 64 + d) * SEQ + s);
            LAS u32x2* dp = (LAS u32x2*)(lds + AT_VT + d * AT_VPITCH + ch * 16); dp[0] = (u32x2){w.x, w.y}; dp[1] = (u32x2){w.z, w.w}; }
#pragma unroll
        for (int g = 0; g < 4; ++g) { const int rel = tid - 256; TAB[g * 512 + tid] = (rel >= -128 && rel <= 128) ? rel_bias[t5_bucket(rel) * NH + kvh * 4 + g] * LOG2E : -1.0e30f; }
        __syncthreads();
        const int g = wave >> 1, h = kvh * 4 + g, q = lane & 31, hh = lane >> 5;
        const float sk = sink[h] * LOG2E;
        for (int qb = 0; qb < 2; ++qb) {
            const int qoff = (wave & 1) * 64 + qb * 32, qloc = qoff + q; const size_t tok = (size_t)b * SEQ + 128 * nb + qloc;
            bf16x8 qf[4];
#pragma unroll
            for (int ks = 0; ks < 4; ++ks) qf[ks] = *(const bf16x8*)(Q + tok * AW + h * 64 + 16 * ks + 8 * hh);
            float mrun = sk, lrun = 1.f; f32x16 O0, O1;
#pragma unroll
            for (int r = 0; r < 16; ++r) { O0[r] = 0.f; O1[r] = 0.f; }
            int tlo = qoff >> 5, thi = tlo + 8; if (nb == 0 && tlo < 4) tlo = 4; if (nb == 127 && thi > 7) thi = 7;
            const LAS float* tb = TAB + g * 512 + 128 - qloc;
            for (int t = tlo; t <= thi; ++t) {
                f32x16 S;
#pragma unroll
                for (int r = 0; r < 16; ++r) S[r] = tb[32 * t + crow(r, hh)];
                const int krow = 32 * t + q;
#pragma unroll
                for (int ks = 0; ks < 4; ++ks) { const bf16x8 kf = *(const LAS bf16x8*)(lds + AT_K + krow * 128 + (((2 * ks + hh) ^ (krow & 7)) << 4));
                    S = __builtin_amdgcn_mfma_f32_32x32x16_bf16(kf, qf[ks], S, 0, 0, 0); }
                float tmax = -3.0e38f;
#pragma unroll
                for (int r = 0; r < 16; ++r) tmax = fmaxf(tmax, S[r]);
                tmax = x32_max(tmax);
                const float mnew = fmaxf(mrun, tmax), alpha = fexp2(mrun - mnew); mrun = mnew;
                float ps = 0.f;
#pragma unroll
                for (int r = 0; r < 16; ++r) { S[r] = fexp2(S[r] - mnew); ps += S[r]; }
                ps = x32_sum(ps);
                lrun = lrun * alpha + ps;
#pragma unroll
                for (int r = 0; r < 16; ++r) { O0[r] *= alpha; O1[r] *= alpha; }
                u32x4 p0, p1;
                p0.x = cvt_pk_bf16(S[0], S[1]); p0.y = cvt_pk_bf16(S[2], S[3]); p0.z = cvt_pk_bf16(S[4], S[5]); p0.w = cvt_pk_bf16(S[6], S[7]);
                p1.x = cvt_pk_bf16(S[8], S[9]); p1.y = cvt_pk_bf16(S[10], S[11]); p1.z = cvt_pk_bf16(S[12], S[13]); p1.w = cvt_pk_bf16(S[14], S[15]);
                const bf16x8 pf0 = __builtin_bit_cast(bf16x8, p0), pf1 = __builtin_bit_cast(bf16x8, p1);
#pragma unroll
                for (int s = 0; s < 2; ++s) {
                    const int kofs = (32 * t + 16 * s + 4 * hh) * 2;
                    const LAS unsigned char* v0 = lds + AT_VT + q * AT_VPITCH + kofs; const LAS unsigned char* v1 = v0 + 32 * AT_VPITCH;
                    const u32x2 a0 = *(const LAS u32x2*)(v0), a1 = *(const LAS u32x2*)(v0 + 16), c0 = *(const LAS u32x2*)(v1), c1 = *(const LAS u32x2*)(v1 + 16);
                    const bf16x8 vf0 = __builtin_bit_cast(bf16x8, (u32x4){a0.x, a0.y, a1.x, a1.y}), vf1 = __builtin_bit_cast(bf16x8, (u32x4){c0.x, c0.y, c1.x, c1.y});
                    O0 = __builtin_amdgcn_mfma_f32_32x32x16_bf16(vf0, s == 0 ? pf0 : pf1, O0, 0, 0, 0);
                    O1 = __builtin_amdgcn_mfma_f32_32x32x16_bf16(vf1, s == 0 ? pf0 : pf1, O1, 0, 0, 0);
                }
            }
            const float inv = 1.0f / lrun;
            bf16_t* op = AH + tok * AHW + h * 64 + 4 * hh;
#pragma unroll
            for (int r4 = 0; r4 < 4; ++r4) {
                u32x2 w0, w1; w0.x = cvt_pk_bf16(O0[4 * r4] * inv, O0[4 * r4 + 1] * inv); w0.y = cvt_pk_bf16(O0[4 * r4 + 2] * inv, O0[4 * r4 + 3] * inv);
                w1.x = cvt_pk_bf16(O1[4 * r4] * inv, O1[4 * r4 + 1] * inv); w1.y = cvt_pk_bf16(O1[4 * r4 + 2] * inv, O1[4 * r4 + 3] * inv);
                *(u32x2*)(op + 8 * r4) = w0; *(u32x2*)(op + 32 + 8 * r4) = w1; }
        }
    }
    __syncthreads();
}

__device__ __forceinline__ bool in_range(int k, int lo, int hi) { asm volatile("" : "+s"(lo), "+s"(hi)); return lo <= k && k < hi; }
constexpr int PH_PER_LAYER = 10, N_PHASES = 1 + DEPTH * PH_PER_LAYER + 1;
__global__ void __launch_bounds__(NTHR, 2) mk_fwd(Args args) {
    extern __shared__ __attribute__((aligned(16))) unsigned char lds_raw[];
    Frame F;
    F.lds = (LAS unsigned char*)lds_raw; F.MISC = (volatile LAS unsigned*)(F.lds + MISC_OFF);
    F.tid = threadIdx.x; F.lane = F.tid & 63; F.wave = __builtin_amdgcn_readfirstlane(F.tid >> 6);
    F.G = gridDim.x; F.bid = blockIdx.x; F.vcu = F.bid;
    F.ws = args.ws; F.ctl = (unsigned*)(args.ws + WS_CTL);
    for (int u = F.tid; u < (LDS_BYTES - RING_BYTES) / 4; u += NTHR) ((LAS unsigned*)(F.lds + RING_BYTES))[u] = 0u;
    __syncthreads();
    if (MK_N_LAUNCHES == 1) (void)xcd_barrier_post(F.ctl + CW_BAR, F.MISC + 8);
    if (PROBE_MODE && threadIdx.x == 0) { volatile LAS unsigned long long* ps = (volatile LAS unsigned long long*)(F.lds + RING_BYTES + 1024); ps[0] = 0; ps[1] = 0; ps[2] = __builtin_amdgcn_s_memrealtime(); }
    const int lo = args.ph_lo, hi = args.ph_hi;
#if MK_N_LAUNCHES == 1
#define IN(k) true
#else
#define IN(k) in_range((k), lo, hi)
#endif
#define PHASE_BEGIN() do { int _tz = threadIdx.x; asm volatile("" : "+v"(_tz)); F.tid = _tz; F.lane = _tz & 63; size_t _z = 0; int _g = gridDim.x, _b = blockIdx.x; asm volatile("" : "+s"(_z), "+s"(_g), "+s"(_b)); F.ws = args.ws + _z; F.G = _g; F.bid = _b; F.vcu = (_g % 8 == 0) ? (_b % 8) * (_g / 8) + _b / 8 : _b; } while (0)
#define SEAM(k) do { if (IN(k) && IN((k) + 1)) { if (USE_FILLER && MK_N_LAUNCHES == 1 && (k) <= 18) { PHASE_BEGIN(); const int _pl = (EI_LAYER + F.G - 1) / F.G; seam_filler(F, args, (k), (k) >= 18 ? 2 * _pl : ((k) >= 8 ? _pl : 0)); } XcdBarrier _b; _b.bar = (unsigned*)(args.ws + WS_CTL) + CW_BAR; _b.x = 0; _b.st = F.MISC + 8; \
        unsigned long long _t0 = 0; if (PROBE_MODE == 2 && threadIdx.x == 0) _t0 = __builtin_amdgcn_s_memrealtime(); \
        if (PROBE_MODE == 3 && threadIdx.x == 0 && (k) == PROBE_K) { volatile LAS unsigned long long* _ps = (volatile LAS unsigned long long*)(F.lds + RING_BYTES + 1024); _ps[5] = __builtin_amdgcn_s_memtime(); _ps[6] = __builtin_amdgcn_s_memrealtime(); } \
        xcd_barrier(_b); \
        if (PROBE_MODE == 3 && threadIdx.x == 0 && (k) == PROBE_K - 1) { volatile LAS unsigned long long* _ps = (volatile LAS unsigned long long*)(F.lds + RING_BYTES + 1024); _ps[3] = __builtin_amdgcn_s_memtime(); _ps[4] = __builtin_amdgcn_s_memrealtime(); } \
        if (PROBE_MODE && threadIdx.x == 0) { const unsigned long long _t1 = __builtin_amdgcn_s_memrealtime(); volatile LAS unsigned long long* _ps = (volatile LAS unsigned long long*)(F.lds + RING_BYTES + 1024); \
            if (PROBE_MODE == 1) { if ((k) == PROBE_K - 1) _ps[0] = _t1; if ((k) == PROBE_K) _ps[1] = _t1; } else if (PROBE_MODE == 2) { _ps[0] = _ps[0] + (_t1 - _t0); } } } } while (0)
    const float* x_in = args.in[0]; float* xo = args.out;
#define WB(off) wsb(F, (off))
    if (PH_ON(0) && IN(0)) REPS(0) { PHASE_BEGIN(); p0_prologue(F, args); __syncthreads(); }
    if (MK_N_LAUNCHES != 1) SEAM(0);
    for (int l = 0; l < DEPTH; ++l) {
        const int pb = 1 + l * PH_PER_LAYER;
        const size_t wlo = WS_W + (size_t)l * W_LAYER;
        if (PH_ON(1) && IN(pb + 0)) REPS(1) { if (_rep && l) break; PHASE_BEGIN(); if (l == 0) rp1<false, false, false, true>(F, x_in, nullptr, WB(WS_H), nullptr); else rp1<true, true, false, false>(F, nullptr, nullptr, WB(WS_H), nullptr); }
        SEAM(pb + 0);
        if (IN(pb + 1)) {
            if (PH_ON(2)) REPS(2) { PHASE_BEGIN(); PInM p{WB(WS_H), WB(wlo + WO_INM), WB(WS_MIX + MX_Q), WB(WS_MIX + MX_K), WB(WS_MIX + MX_VT), WB(WS_MIX + MX_GR), WB(WS_MIX + MX_GB)}; gm::gemm_phase(F.lds, p, F.G, F.bid, F.tid); }
            if (PH_ON(3)) REPS(3) { PHASE_BEGIN(); PInF p{WB(wlo + WO_F), WB(WS_H), WB(WS_MIX + MX_FT)}; gm::gemm_phase(F.lds, p, F.G, F.bid, F.tid); }
        }
        SEAM(pb + 1);
        if (IN(pb + 2)) {
            if (PH_ON(4)) REPS(4) { PHASE_BEGIN(); attn_phase(F, WB(WS_MIX + MX_Q), WB(WS_MIX + MX_K), WB(WS_MIX + MX_VT), WB(WS_MIX + MX_AH), args.in[1], args.in[4] + l * NH); }
            if (PH_ON(5)) REPS(5) { PHASE_BEGIN(); PF1 p{WB(WS_F1), WB(WS_MIX + MX_FT), WB(WS_MIX + MX_QP), (const float*)(F.ws + WS_TWC), (const float*)(F.ws + WS_TWS)}; gm::gemm_phase(F.lds, p, F.G, F.bid, F.tid); }
        }
        SEAM(pb + 2);
        if (PH_ON(6) && IN(pb + 3)) REPS(6) { PHASE_BEGIN(); PF2 p{WB(WS_G2), WB(WS_MIX + MX_QP), WB(WS_MIX + MX_AH)}; gm::gemm_phase(F.lds, p, F.G, F.bid, F.tid); }
        SEAM(pb + 3);
        if (PH_ON(7) && IN(pb + 4)) REPS(7) { PHASE_BEGIN(); PMg p{WB(WS_MIX + MX_AH), WB(wlo + WO_MG), WB(WS_MIX + MX_GR), WB(WS_MIX + MX_GB), WB(WS_MIX + MX_MG)}; gm::gemm_phase(F.lds, p, F.G, F.bid, F.tid); }
        SEAM(pb + 4);
        if (PH_ON(8) && IN(pb + 5)) REPS(8) { if (_rep && l) break; PHASE_BEGIN(); POut p{WB(WS_MIX + MX_MG), WB(wlo + WO_OUT), l == 0 ? x_in : (const float*)nullptr, WB(WS_XB)}; gm::gemm_phase(F.lds, p, F.G, F.bid, F.tid); }
        SEAM(pb + 5);
        if (PH_ON(9) && IN(pb + 6)) REPS(9) { PHASE_BEGIN(); if (FFN_FP8) rp2_mfma(F, WB(WS_H), l); else rp2(F, WB(WS_H), l); }
        SEAM(pb + 6);
        if (PH_ON(10) && IN(pb + 7)) REPS(10) { PHASE_BEGIN(); topk_phase(F, args, l); }
        SEAM(pb + 7);
        if (PH_ON(11) && IN(pb + 8)) REPS(11) { PHASE_BEGIN(); PUp p{WB(WS_H), WB(wlo + WO_GU), (const int*)(F.ws + WS_SELTOK), WB(WS_ACT)}; gm::gemm_phase(F.lds, p, F.G, F.bid, F.tid); }
        SEAM(pb + 8);
        if (PH_ON(12) && IN(pb + 9)) REPS(12) { PHASE_BEGIN(); PDn p{WB(WS_ACT), WB(wlo + WO_D), (const float*)(F.ws + WS_SELGATE), WB(WS_Y)}; gm::gemm_phase(F.lds, p, F.G, F.bid, F.tid); }
        SEAM(pb + 9);
    }
    if (PH_ON(13) && IN(N_PHASES - 1)) { PHASE_BEGIN(); rp1<true, false, true, false>(F, nullptr, xo, nullptr, args.in[13]); }
#undef WB
    if (PROBE_MODE) {
        volatile LAS unsigned long long* ps = (volatile LAS unsigned long long*)(F.lds + RING_BYTES + 1024);
        unsigned long long* acc64 = (unsigned long long*)(args.ws + WS_CTL) + 1024;
        if (PROBE_MODE == 2) { if (threadIdx.x == 0) atomicAdd(acc64, ps[0]); XcdBarrier _b; _b.bar = (unsigned*)(args.ws + WS_CTL) + CW_BAR; _b.x = 0; _b.st = F.MISC + 8; xcd_barrier(_b); }
        if (blockIdx.x == 0 && threadIdx.x == 0) {
            unsigned long long d;
            if (PROBE_MODE == 1) { const unsigned long long a = (PROBE_K == 0) ? ps[2] : ps[0]; d = ps[1] - a; }
            else if (PROBE_MODE == 3) { const unsigned long long cyc = ps[5] - ps[3], rt = ps[6] - ps[4]; d = (rt ? (cyc * 100ull / rt) : 0ull) * 100ull / PROBE_AMP; }
            else d = __hip_atomic_load(acc64, __ATOMIC_RELAXED, __HIP_MEMORY_SCOPE_AGENT) / gridDim.x;
            const unsigned long long t0 = __builtin_amdgcn_s_memrealtime();
            while (__builtin_amdgcn_s_memrealtime() - t0 < d * PROBE_AMP) __builtin_amdgcn_s_sleep(16);
        }
    }
#undef IN
#undef SEAM
}

extern "C" void kernel_launch(void* const* d_in, const int* in_sizes, int n_in, void* d_out, int out_size, void* d_ws, size_t ws_size, hipStream_t stream) {
    static int grid = 0;
    if (grid == 0) {
        if (n_in != 14 || out_size != T * D || ws_size < WS_END) { fprintf(stderr, "kernel_launch: unexpected shapes (n_in %d out %d ws %zu); nothing launched\n", n_in, out_size, ws_size); grid = -1; return; }
        int dev = 0, cus = 0, per_cu = 0;
        if (hipGetDevice(&dev) != hipSuccess || hipDeviceGetAttribute(&cus, hipDeviceAttributeMultiprocessorCount, dev) != hipSuccess) { grid = -1; return; }
        if (hipFuncSetAttribute((const void*)mk_fwd, hipFuncAttributeMaxDynamicSharedMemorySize, LDS_BYTES) != hipSuccess) { fprintf(stderr, "kernel_launch: hipFuncSetAttribute failed\n"); grid = -1; return; }
        if (hipOccupancyMaxActiveBlocksPerMultiprocessor(&per_cu, (const void*)mk_fwd, NTHR, LDS_BYTES) != hipSuccess || per_cu < 1) fprintf(stderr, "kernel_launch: occupancy query says %d\n", per_cu);
        (void)hipGetLastError();
        grid = cus;
    }
    if (grid < 0) return;
    (void)hipMemsetAsync((char*)d_ws + WS_CTL, 0, CTL_ZERO_BYTES, stream);
    Args a{};
    for (int i = 0; i < 14; ++i) a.in[i] = (const float*)d_in[i];
    a.out = (float*)d_out; a.ws = (unsigned char*)d_ws;
#if MK_N_LAUNCHES == 1
    a.ph_lo = 0; a.ph_hi = N_PHASES; a.li = 0;
    hipLaunchKernelGGL(mk_fwd, dim3(grid), dim3(NTHR), LDS_BYTES, stream, a);
#else
    for (int ph = 0; ph < N_PHASES; ++ph) { a.ph_lo = ph; a.ph_hi = ph + 1; a.li = ph; hipLaunchKernelGGL(mk_fwd, dim3(grid), dim3(NTHR), LDS_BYTES, stream, a); }
#endif
}
```

```cpp
#include <hip/hip_runtime.h>
#include <cstdio>
#include <cstdint>

#define LAS __attribute__((address_space(3)))
#define GAS __attribute__((address_space(1)))
typedef unsigned short bf16_t;
typedef short bf16x8 __attribute__((ext_vector_type(8)));
typedef float f32x4 __attribute__((ext_vector_type(4)));
typedef float f32x16 __attribute__((ext_vector_type(16)));
typedef unsigned u32x4 __attribute__((ext_vector_type(4)));
typedef unsigned u32x2 __attribute__((ext_vector_type(2)));
typedef GAS unsigned gu32;
typedef int v8i32 __attribute__((ext_vector_type(8)));
typedef int v4i32 __attribute__((ext_vector_type(4)));

#ifndef MK_N_LAUNCHES
#define MK_N_LAUNCHES 1
#endif
#ifndef FFN_FP8
#define FFN_FP8 1
#endif
#ifndef USE_FILLER
#define USE_FILLER 0
#endif
#ifndef PH_MASK
#define PH_MASK 0xffff
#endif
#define PH_ON(k) ((PH_MASK >> (k)) & 1)
#ifndef PH_REP
#define PH_REP 0
#endif
#ifndef PROBE_MODE
#define PROBE_MODE 0
#endif
#ifndef PROBE_K
#define PROBE_K 0
#endif
#define PROBE_AMP 4
#define REPS(k) _Pragma("nounroll") for (int _rep = 0; _rep < 1 + ((PH_REP >> (k)) & 1); ++_rep)

constexpr int D = 1024, BATCH = 2, SEQ = 16384, T = BATCH * SEQ, DEPTH = 2;
constexpr int NH = 8, HD = 64, AW = 512, KVW = 128, FW = 512, INW = 3328;
constexpr int NE = 16, CAP = 2048, DFF = 2816, NSLOT = BATCH * NE * CAP;
constexpr float EPS = 1e-6f, LOG2E = 1.4426950408889634f;
constexpr int AHW = 1536;
constexpr int NWAVES = 8, NTHR = 512;

constexpr size_t MiB = 1u << 20, KiB = 1024;
constexpr size_t WS_CTL = 0, CTL_ZERO_BYTES = 1 * MiB;
constexpr size_t WS_F1 = 1 * MiB, WS_G2 = WS_F1 + 64 * KiB, WS_TWC = WS_G2 + 128 * KiB, WS_TWS = WS_TWC + 64 * KiB, WS_WRT = WS_TWS + 64 * KiB,
                 WS_SELTOK = WS_WRT + 128 * KiB, WS_SELGATE = WS_SELTOK + 256 * KiB;
static_assert(WS_SELGATE + 256 * KiB <= 2 * MiB, "misc map");
constexpr size_t WS_AFF = 2 * MiB, WS_SLOT = 4 * MiB;
constexpr size_t WS_W = 8 * MiB, W_LAYER = 276 * MiB;
constexpr size_t WO_INM = 0, WO_F = 6 * MiB, WO_MG = 7 * MiB, WO_OUT = 10 * MiB, WO_GU = 12 * MiB, WO_D = 188 * MiB;
constexpr size_t WS_H = 560 * MiB, WS_Y = 624 * MiB, WS_MIX = 752 * MiB, WS_ACT = 752 * MiB;
constexpr size_t MX_Q = 0, MX_K = 32 * MiB, MX_VT = 40 * MiB, MX_FT = 48 * MiB, MX_GR = 80 * MiB, MX_GB = 144 * MiB, MX_AH = 208 * MiB, MX_QP = 304 * MiB, MX_MG = 368 * MiB;
constexpr size_t WS_XB = 1184 * MiB;
constexpr size_t WS_END = 1248 * MiB;
static_assert(WS_W + 2 * W_LAYER <= WS_H && WS_MIX + MX_MG + 64 * MiB <= WS_END && WS_ACT + (size_t)NSLOT * DFF * 2 <= WS_END, "ws map");

constexpr int CW_BAR = 4096, CW_QEXP = 16384, QDYN_ROUNDS = 1;

constexpr int RING_BYTES = 131072, MISC_OFF = RING_BYTES + 320, LDS_BYTES = 147456;

__device__ __forceinline__ unsigned f2bf(float f) { unsigned u = __builtin_bit_cast(unsigned, f); return (u + 0x7fffu + ((u >> 16) & 1u)) >> 16; }
__device__ __forceinline__ unsigned pk2(float lo, float hi) { return f2bf(lo) | (f2bf(hi) << 16); }
__device__ __forceinline__ unsigned cvt_pk_bf16(float lo, float hi) { unsigned r; asm volatile("v_cvt_pk_bf16_f32 %0, %1, %2" : "=v"(r) : "v"(lo), "v"(hi)); return r; }
__device__ __forceinline__ u32x4 pack8(const f32x4 a, const f32x4 b) { u32x4 w; w.x = cvt_pk_bf16(a[0], a[1]); w.y = cvt_pk_bf16(a[2], a[3]); w.z = cvt_pk_bf16(b[0], b[1]); w.w = cvt_pk_bf16(b[2], b[3]); return w; }
__device__ __forceinline__ float bflo(unsigned w) { return __builtin_bit_cast(float, w << 16); }
__device__ __forceinline__ float bfhi(unsigned w) { return __builtin_bit_cast(float, w & 0xffff0000u); }
__device__ __forceinline__ void unpack8(const u32x4 w, f32x4& a, f32x4& b) { a[0] = bflo(w.x); a[1] = bfhi(w.x); a[2] = bflo(w.y); a[3] = bfhi(w.y); b[0] = bflo(w.z); b[1] = bfhi(w.z); b[2] = bflo(w.w); b[3] = bfhi(w.w); }
__device__ __forceinline__ float fexp2(float x) { return __builtin_amdgcn_exp2f(x); }
__device__ __forceinline__ float frcp(float x) { return __builtin_amdgcn_rcpf(x); }
#define A8(x) x##0, x##1, x##2, x##3, x##4, x##5, x##6, x##7
__device__ __forceinline__ void mul8_s(float (&d)[8], float s, const float (&a)[8]) {
    asm("v_mul_f32_e32 %0, %16, %8\n\tv_mul_f32_e32 %1, %16, %9\n\tv_mul_f32_e32 %2, %16, %10\n\tv_mul_f32_e32 %3, %16, %11\n\tv_mul_f32_e32 %4, %16, %12\n\tv_mul_f32_e32 %5, %16, %13\n\tv_mul_f32_e32 %6, %16, %14\n\tv_mul_f32_e32 %7, %16, %15"
        : "=&v"(d[0]), "=&v"(d[1]), "=&v"(d[2]), "=&v"(d[3]), "=&v"(d[4]), "=&v"(d[5]), "=&v"(d[6]), "=&v"(d[7])
        : "v"(a[0]), "v"(a[1]), "v"(a[2]), "v"(a[3]), "v"(a[4]), "v"(a[5]), "v"(a[6]), "v"(a[7]), "s"(s));
}
__device__ __forceinline__ void fma8_ss_trans(float (&e)[8], float s) {
    asm("s_nop 0\n\tv_fma_f32 %0, %0, %8, %8\n\tv_fma_f32 %1, %1, %8, %8\n\tv_fma_f32 %2, %2, %8, %8\n\tv_fma_f32 %3, %3, %8, %8\n\tv_fma_f32 %4, %4, %8, %8\n\tv_fma_f32 %5, %5, %8, %8\n\tv_fma_f32 %6, %6, %8, %8\n\tv_fma_f32 %7, %7, %8, %8"
        : "+v"(e[0]), "+v"(e[1]), "+v"(e[2]), "+v"(e[3]), "+v"(e[4]), "+v"(e[5]), "+v"(e[6]), "+v"(e[7]) : "s"(s));
}
__device__ __forceinline__ void mul8(float (&d)[8], const float (&a)[8], const float (&b)[8]) {
    asm("v_mul_f32_e32 %0, %8, %16\n\tv_mul_f32_e32 %1, %9, %17\n\tv_mul_f32_e32 %2, %10, %18\n\tv_mul_f32_e32 %3, %11, %19\n\tv_mul_f32_e32 %4, %12, %20\n\tv_mul_f32_e32 %5, %13, %21\n\tv_mul_f32_e32 %6, %14, %22\n\tv_mul_f32_e32 %7, %15, %23"
        : "=&v"(d[0]), "=&v"(d[1]), "=&v"(d[2]), "=&v"(d[3]), "=&v"(d[4]), "=&v"(d[5]), "=&v"(d[6]), "=&v"(d[7])
        : "v"(a[0]), "v"(a[1]), "v"(a[2]), "v"(a[3]), "v"(a[4]), "v"(a[5]), "v"(a[6]), "v"(a[7]), "v"(b[0]), "v"(b[1]), "v"(b[2]), "v"(b[3]), "v"(b[4]), "v"(b[5]), "v"(b[6]), "v"(b[7]));
}
__device__ __forceinline__ void mul8_trans(float (&d)[8], const float (&r)[8]) {
    asm("s_nop 0\n\tv_mul_f32_e32 %0, %0, %8\n\tv_mul_f32_e32 %1, %1, %9\n\tv_mul_f32_e32 %2, %2, %10\n\tv_mul_f32_e32 %3, %3, %11\n\tv_mul_f32_e32 %4, %4, %12\n\tv_mul_f32_e32 %5, %5, %13\n\tv_mul_f32_e32 %6, %6, %14\n\tv_mul_f32_e32 %7, %7, %15"
        : "+v"(d[0]), "+v"(d[1]), "+v"(d[2]), "+v"(d[3]), "+v"(d[4]), "+v"(d[5]), "+v"(d[6]), "+v"(d[7])
        : "v"(r[0]), "v"(r[1]), "v"(r[2]), "v"(r[3]), "v"(r[4]), "v"(r[5]), "v"(r[6]), "v"(r[7]));
}
template <int CTRL> __device__ __forceinline__ float dpp_mov(float v) { return __builtin_bit_cast(float, __builtin_amdgcn_mov_dpp(__builtin_bit_cast(int, v), CTRL, 0xF, 0xF, true)); }
template <int O> __device__ __forceinline__ float swz_xor(float v) {
    if constexpr (O == 1) return dpp_mov<0xB1>(v);
    else if constexpr (O == 2) return dpp_mov<0x4E>(v);
    else if constexpr (O == 4) { int t = __builtin_amdgcn_update_dpp(0, __builtin_bit_cast(int, v), 0x104, 0xF, 0x5, false); t = __builtin_amdgcn_update_dpp(t, __builtin_bit_cast(int, v), 0x114, 0xF, 0xA, false); return __builtin_bit_cast(float, t); }
    else { static_assert(O == 8, "swz_xor: O in {1,2,4,8}"); return dpp_mov<0x128>(v); }
}
__device__ __forceinline__ float x32_sum(float v) { const unsigned u = __builtin_bit_cast(unsigned, v); auto r = __builtin_amdgcn_permlane32_swap(u, u, false, false); return __builtin_bit_cast(float, (unsigned)r[0]) + __builtin_bit_cast(float, (unsigned)r[1]); }
__device__ __forceinline__ float x32_max(float v) { const unsigned u = __builtin_bit_cast(unsigned, v); auto r = __builtin_amdgcn_permlane32_swap(u, u, false, false); return fmaxf(__builtin_bit_cast(float, (unsigned)r[0]), __builtin_bit_cast(float, (unsigned)r[1])); }
__device__ __forceinline__ float x32_get(float v, bool up) { const unsigned u = __builtin_bit_cast(unsigned, v); auto r = __builtin_amdgcn_permlane32_swap(u, u, false, false); return __builtin_bit_cast(float, up ? (unsigned)r[0] : (unsigned)r[1]); }
__device__ __forceinline__ float x16_sum(float v) { const unsigned u = __builtin_bit_cast(unsigned, v); auto r = __builtin_amdgcn_permlane16_swap(u, u, false, false); return __builtin_bit_cast(float, (unsigned)r[0]) + __builtin_bit_cast(float, (unsigned)r[1]); }
__device__ __forceinline__ float x16_max(float v) { const unsigned u = __builtin_bit_cast(unsigned, v); auto r = __builtin_amdgcn_permlane16_swap(u, u, false, false); return fmaxf(__builtin_bit_cast(float, (unsigned)r[0]), __builtin_bit_cast(float, (unsigned)r[1])); }
__device__ __forceinline__ float x16_get(float v, bool odd) { const unsigned u = __builtin_bit_cast(unsigned, v); auto r = __builtin_amdgcn_permlane16_swap(u, u, false, false); return __builtin_bit_cast(float, odd ? (unsigned)r[0] : (unsigned)r[1]); }
__device__ __forceinline__ float wave_sum(float v) { v += dpp_mov<0xB1>(v); v += dpp_mov<0x4E>(v); v += dpp_mov<0x141>(v); v += dpp_mov<0x140>(v); v = x16_sum(v); return x32_sum(v); }
__device__ __forceinline__ int wave_sum_i(int v) { return (int)wave_sum((float)v); }
#define LDS_WAIT() asm volatile("s_waitcnt lgkmcnt(0)" ::: "memory")
#define VM_WAIT() asm volatile("s_waitcnt vmcnt(0)" ::: "memory")

#define XB_TMO      128
#define XB_XCNT(j)  (256  + 64 * (j))
#define XB_XSUB(j)  (1280 + 64 * (j))
#define XB_XGEN(j)  (2304 + 64 * (j))
#define XB_TOP      3328
#define XB_TOPGEN   3392
#define XCD_BAR_WORDS 3456
#define XB_SPIN_CAP (1u << 22)
__device__ __forceinline__ unsigned xb_ld(unsigned* p)              { return __hip_atomic_load(p, __ATOMIC_RELAXED, __HIP_MEMORY_SCOPE_AGENT); }
__device__ __forceinline__ unsigned xb_add(unsigned* p, unsigned v) { return __hip_atomic_fetch_add(p, v, __ATOMIC_RELAXED, __HIP_MEMORY_SCOPE_AGENT); }
__device__ __forceinline__ unsigned xb_xcc_id() { return (unsigned)__builtin_amdgcn_s_getreg((3 << 11) | 20) & 0xFu; }
#define XB_SPIN(cond, bar) do { unsigned _sp = 0; while (cond) { __builtin_amdgcn_s_sleep(1); \
    if ((++_sp & 255u) == 0u) { if (xb_ld(&(bar)[XB_TMO])) break; if (_sp > XB_SPIN_CAP) { atomicAdd(&(bar)[XB_TMO], 1u); break; } } } } while (0)
struct XcdBarrier { unsigned* bar; unsigned x; volatile LAS unsigned* st; };
__device__ __forceinline__ XcdBarrier xcd_barrier_post(unsigned* bar, volatile LAS unsigned* st) {
    XcdBarrier b; b.bar = bar; b.x = xb_xcc_id(); b.st = st;
    if (threadIdx.x == 0) (void)xb_add(&bar[XB_XCNT(b.x)], 1u);
    return b;
}
__device__ __forceinline__ void xcd_barrier_complete(unsigned* bar, unsigned x, unsigned& nloc, unsigned& nx) {
    const unsigned G = gridDim.x * gridDim.y * gridDim.z;
    unsigned sum, cnt, mine, sp = 0u;
    for (;;) {
        sum = 0u; cnt = 0u; mine = 0u;
        unsigned cv[16];
#pragma unroll
        for (int hq = 0; hq < 2; ++hq) { const unsigned* pb = bar + XB_XCNT(8 * hq);
            asm volatile("global_load_dword %0, %8, off sc1\n\tglobal_load_dword %1, %8, off offset:256 sc1\n\tglobal_load_dword %2, %8, off offset:512 sc1\n\tglobal_load_dword %3, %8, off offset:768 sc1\n\t"
                         "global_load_dword %4, %8, off offset:1024 sc1\n\tglobal_load_dword %5, %8, off offset:1280 sc1\n\tglobal_load_dword %6, %8, off offset:1536 sc1\n\tglobal_load_dword %7, %8, off offset:1792 sc1"
                         : "=&v"(cv[8 * hq]), "=&v"(cv[8 * hq + 1]), "=&v"(cv[8 * hq + 2]), "=&v"(cv[8 * hq + 3]), "=&v"(cv[8 * hq + 4]), "=&v"(cv[8 * hq + 5]), "=&v"(cv[8 * hq + 6]), "=&v"(cv[8 * hq + 7]) : "v"(pb) : "memory"); }
        asm volatile("s_waitcnt vmcnt(0)" ::: "memory");
#pragma unroll
        for (int j = 0; j < 16; ++j) asm volatile("" : "+v"(cv[j]));
#pragma unroll
        for (unsigned j = 0; j < 16; ++j) { const unsigned c = cv[j]; sum += c; cnt += (c > 0u) ? 1u : 0u; mine = (j == x) ? c : mine; }
        if (sum == G) break;
        __builtin_amdgcn_s_sleep(1);
        if ((++sp & 255u) == 0u) { if (xb_ld(&bar[XB_TMO])) break; if (sp > XB_SPIN_CAP) { atomicAdd(&bar[XB_TMO], 1u); break; } }
    }
    nloc = mine > 0u ? mine : 1u; nx = cnt > 0u ? cnt : 1u;
}
__device__ __forceinline__ void xcd_barrier(const XcdBarrier& b_) {
    XcdBarrier b = b_; b.x = xb_xcc_id();
    asm volatile("s_waitcnt vmcnt(0)" ::: "memory");
    __syncthreads();
    if (threadIdx.x == 0) {
        unsigned* bar = b.bar;
        __builtin_amdgcn_s_waitcnt(0);
        unsigned nloc = b.st[0], nx = b.st[1];
        if (nloc == 0u) { xcd_barrier_complete(bar, b.x, nloc, nx); b.st[0] = nloc; b.st[1] = nx; }
        const unsigned old = xb_add(&bar[XB_XSUB(b.x)], 1u);
        const unsigned gen = old / nloc;
        if (old + 1u == (gen + 1u) * nloc) {
            __builtin_amdgcn_fence(__ATOMIC_RELEASE, "agent");
            asm volatile("s_waitcnt vmcnt(0)" ::: "memory");
            const unsigned og = xb_add(&bar[XB_TOP], 1u);
            const unsigned tg = og / nx;
            if (og + 1u == (tg + 1u) * nx) xb_add(&bar[XB_TOPGEN], 1u);
            else XB_SPIN(xb_ld(&bar[XB_TOPGEN]) == tg, bar);
            __builtin_amdgcn_fence(__ATOMIC_ACQUIRE, "agent");
            xb_add(&bar[XB_XGEN(b.x)], 1u);
            asm volatile("s_waitcnt vmcnt(0)" ::: "memory");
        } else {
            XB_SPIN(xb_ld(&bar[XB_XGEN(b.x)]) == gen, bar);
            __builtin_amdgcn_fence(__ATOMIC_ACQUIRE, "agent");
            asm volatile("s_waitcnt vmcnt(0)" ::: "memory");
        }
    }
    __syncthreads();
}

namespace gm {
constexpr int BM = 256, BK = 64, HALF = 128, HTB = HALF * BK * 2, NXCD = 8, WGM = 4;
__host__ __device__ __forceinline__ int lds_byte(int r, int c) { const int st = (r >> 4) * 2 + (c >> 5), rr = r & 15, cc = c & 31, ob = rr * 64 + cc * 2; return st * 1024 + (ob ^ (((ob >> 9) & 1) << 5)); }
__host__ __device__ __forceinline__ void stage_rc(int b, int& R, int& C) { const int st = b / 1024, sb = b % 1024, swz = sb ^ (((sb >> 9) & 1) << 5); R = (st >> 1) * 16 + swz / 64; C = (st & 1) * 32 + (swz % 64) / 2; }
__host__ __device__ __forceinline__ int perm32(int rho) { const int n = rho >> 4, i = rho & 15; return 8 * (i >> 2) + 4 * n + (i & 3); }
struct Unit { int pm, pn; };
struct StaticOrder {
    int nM, nN, nwg, G, c;
    __device__ __forceinline__ void init(int nM_, int nN_, int G_, int c_) { nM = nM_; nN = nN_; nwg = nM * nN; G = G_; c = c_; }
    __device__ __forceinline__ bool next(int i, Unit& u) const {
        const long L = (long)i * G + c; if (L >= nwg) return false;
        int wgid = (int)L; { const int q = nwg / NXCD, r = nwg % NXCD, xcd = wgid % NXCD, off = wgid / NXCD; wgid = (xcd < r ? xcd * (q + 1) : r * (q + 1) + (xcd - r) * q) + off; }
        const int nig = WGM * nN, gid = wgid / nig, fm = gid * WGM, gsz = (nM - fm) < WGM ? (nM - fm) : WGM;
        u.pm = fm + ((wgid % nig) % gsz); u.pn = (wgid % nig) / gsz; return true;
    }
};
typedef f32x4 Acc[2][2][4][2];

template <class P>
__device__ __forceinline__ void gemm_phase(LAS unsigned char* lds, const P& p, int G, int cid, int tid) {
    constexpr bool GA = P::GA, GB = P::GB;
    const int wid = __builtin_amdgcn_readfirstlane(tid >> 6), lane = tid & 63, wr = wid >> 2, wc = wid & 3, fr = lane & 15, fq = lane >> 4;
    constexpr int K = P::K, nt = K / BK;
    static_assert(nt >= 2 && (nt % 2) == 0, "K must be a multiple of 128");
    unsigned vA[2], vB[2];
#pragma unroll
    for (int i = 0; i < 2; ++i) { int R, C; stage_rc(tid * 16 + i * 8192, R, C); const int Rb = (R & ~31) + perm32(R & 31); vA[i] = (unsigned)(R * P::ldA + C) * 2u; vB[i] = (unsigned)(Rb * P::ldB + C) * 2u; }
    constexpr size_t hsA = (size_t)HALF * P::ldA * 2, hsB = (size_t)HALF * P::ldB * 2;
    const unsigned ldsw = (unsigned)wid * 1024u;
    const int aoff = lds_byte(wr * 64 + fr, fq * 8), boff = lds_byte(wc * 32 + fr, fq * 8);
    unsigned gA[2][2], gB[2][2]; int preA[2][2];
#define G_GATHER_A(U, USEPRE) do { int _tz = threadIdx.x; asm volatile("" : "+v"(_tz)); _Pragma("unroll") for (int _i = 0; _i < 2; ++_i) { int _R, _C; stage_rc(_tz * 16 + _i * 8192, _R, _C); \
        _Pragma("unroll") for (int _h = 0; _h < 2; ++_h) { const int _row = (USEPRE) ? preA[_h][_i] : p.rowA(U, _h * HALF + _R); gA[_h][_i] = (unsigned)(_row * P::ldA + _C) * 2u; } } } while (0)
#define G_GATHER_B(U) do { int _tz = threadIdx.x; asm volatile("" : "+v"(_tz)); _Pragma("unroll") for (int _i = 0; _i < 2; ++_i) { int _R, _C; stage_rc(_tz * 16 + _i * 8192, _R, _C); const int _Rb = (_R & ~31) + perm32(_R & 31); \
        _Pragma("unroll") for (int _h = 0; _h < 2; ++_h) gB[_h][_i] = (unsigned)(p.rowB(U, _h * HALF + _Rb) * P::ldB + _C) * 2u; } } while (0)
#define G_PREF_A(U) do { int _tz = threadIdx.x; asm volatile("" : "+v"(_tz)); _Pragma("unroll") for (int _i = 0; _i < 2; ++_i) { int _R, _C; stage_rc(_tz * 16 + _i * 8192, _R, _C); \
        _Pragma("unroll") for (int _h = 0; _h < 2; ++_h) preA[_h][_i] = p.rowA(U, _h * HALF + _R); } } while (0)
#define G_SA(b, h) (((b) * 2 + (h)) * HTB)
#define G_SB(b, h) ((4 + (b) * 2 + (h)) * HTB)
#define G_GLDS(src, dstoff) __builtin_amdgcn_global_load_lds((const unsigned*)(src), (LAS unsigned*)(lds + (dstoff)), 16, 0, 0)
#define G_KT(kt) (P::KWRAP ? ((kt) >= P::KWRAP ? (kt) - P::KWRAP : (kt)) : (kt))
#define G_STAGE_A(bufoff, h, kt) do { const char* _b = GA ? (cA + (size_t)G_KT(kt) * 128) : (cA + (size_t)(h) * hsA + (size_t)G_KT(kt) * 128); \
        G_GLDS(_b + (GA ? gA[h][0] : vA[0]), (bufoff) + ldsw); G_GLDS(_b + (GA ? gA[h][1] : vA[1]), (bufoff) + ldsw + 8192); } while (0)
#define G_STAGE_B(bufoff, h, kt) do { const char* _b = GB ? (cB + (size_t)G_KT(kt) * 128) : (cB + (size_t)(h) * hsB + (size_t)G_KT(kt) * 128); \
        G_GLDS(_b + (GB ? gB[h][0] : vB[0]), (bufoff) + ldsw); G_GLDS(_b + (GB ? gB[h][1] : vB[1]), (bufoff) + ldsw + 8192); } while (0)
#define G_LDA(dst, b, h) do { _Pragma("unroll") for (int m = 0; m < 4; ++m) _Pragma("unroll") for (int k = 0; k < 2; ++k) dst[m][k] = *(const LAS bf16x8*)(lds + G_SA(b, h) + aoff + m * 2048 + k * 1024); } while (0)
#define G_LDB(dst, b, h) do { _Pragma("unroll") for (int n = 0; n < 2; ++n) _Pragma("unroll") for (int k = 0; k < 2; ++k) dst[n][k] = *(const LAS bf16x8*)(lds + G_SB(b, h) + boff + n * 2048 + k * 1024); } while (0)
#define G_CAT(x) __builtin_shufflevector(__builtin_bit_cast(v4i32, (x)[0]), __builtin_bit_cast(v4i32, (x)[1]), 0, 1, 2, 3, 4, 5, 6, 7)
#define G_MMA(ai, bj, At, Bt) do { __builtin_amdgcn_s_setprio(1); _Pragma("unroll") for (int m = 0; m < 4; ++m) _Pragma("unroll") for (int n = 0; n < 2; ++n) { \
        if constexpr (P::FP8) { acc[ai][bj][m][n] = __builtin_amdgcn_mfma_scale_f32_16x16x128_f8f6f4(G_CAT(Bt[n]), G_CAT(At[m]), acc[ai][bj][m][n], 0, 0, 0, P::SCALE_B, 0, P::SCALE_A); } \
        else { _Pragma("unroll") for (int k = 0; k < 2; ++k) acc[ai][bj][m][n] = __builtin_amdgcn_mfma_f32_16x16x32_bf16(Bt[n][k], At[m][k], acc[ai][bj][m][n], 0, 0, 0); } } \
        __builtin_amdgcn_s_setprio(0); } while (0)
#define G_WAIT_V(n) asm volatile("s_waitcnt vmcnt(" #n ")" ::: "memory")
#define G_WAIT_L(n) asm volatile("s_waitcnt lgkmcnt(" #n ")" ::: "memory")
#define G_BAR __builtin_amdgcn_s_barrier()
#define G_SCHED __builtin_amdgcn_sched_barrier(0)
    StaticOrder S; S.init(P::nM, P::nN, G, cid);
    Unit cur, nxt; int ui = 0;
    if (!S.next(0, cur)) return;
    Acc acc;
#pragma unroll
    for (int a = 0; a < 2; ++a)
#pragma unroll
        for (int b = 0; b < 2; ++b)
#pragma unroll
            for (int m = 0; m < 4; ++m)
#pragma unroll
                for (int n = 0; n < 2; ++n) acc[a][b][m][n] = (f32x4){0.f, 0.f, 0.f, 0.f};
    bf16x8 At[4][2], B0[2][2], B1[2][2];
    const char* cA = p.tileA(cur); const char* cB = p.tileB(cur);
    if constexpr (GA) { G_GATHER_A(cur, false); }
    if constexpr (GB) { G_GATHER_B(cur); }
    if constexpr (GA) { VM_WAIT(); }
    G_STAGE_B(G_SB(0, 0), 0, 0); G_STAGE_B(G_SB(0, 1), 1, 0); G_STAGE_A(G_SA(0, 0), 0, 0); G_STAGE_A(G_SA(0, 1), 1, 0);
    if (wr == 1) G_BAR;
    G_WAIT_V(2); G_BAR;
    G_STAGE_B(G_SB(1, 0), 0, 1); G_STAGE_A(G_SA(1, 0), 0, 1); G_STAGE_B(G_SB(1, 1), 1, 1);
    G_WAIT_V(6); G_BAR;
    for (;;) {
        const bool has_next = S.next(ui + 1, nxt);
        { size_t _z = 0; asm volatile("" : "+s"(_z)); cA += _z; cB += _z; }
        const char* nA = has_next ? p.tileA(nxt) : cA; const char* nB = has_next ? p.tileB(nxt) : cB;
        if constexpr (GA && P::PREFA) { if (has_next && nxt.pm != cur.pm) { G_PREF_A(nxt); asm volatile("" : "+v"(preA[0][0]), "+v"(preA[0][1]), "+v"(preA[1][0]), "+v"(preA[1][1])); } }
        int ntr = nt; asm volatile("" : "+s"(ntr));
#pragma nounroll
        for (int t = 0; t < ntr; t += 2) {
            const bool last = (t == ntr - 2);
            asm volatile("" : "+v"(vA[0]), "+v"(vA[1]), "+v"(vB[0]), "+v"(vB[1]));
            if constexpr (GA) asm volatile("" : "+v"(gA[0][0]), "+v"(gA[0][1]), "+v"(gA[1][0]), "+v"(gA[1][1]));
            if constexpr (GB) asm volatile("" : "+v"(gB[0][0]), "+v"(gB[0][1]), "+v"(gB[1][0]), "+v"(gB[1][1]));
            if constexpr (P::HOOK_KT > 0) { if (t == P::HOOK_KT) { int tz = threadIdx.x; asm volatile("" : "+v"(tz)); const int wid2 = tz >> 6, lane2 = tz & 63; p.hook(acc, cur, wid2 >> 2, wid2 & 3, lane2 & 15, lane2 >> 4); } }
            G_LDB(B0, 0, 0); G_LDB(B1, 0, 1); G_SCHED; G_LDA(At, 0, 0); G_STAGE_A(G_SA(1, 1), 1, t + 1);
            G_WAIT_V(8); G_WAIT_L(0); G_BAR; G_MMA(0, 0, At, B0); G_MMA(0, 1, At, B1); G_BAR; G_SCHED;
            int kb = t + 2;
            if (last) {
                kb = 0;
                if (has_next) {
                    cA = nA; cB = nB;
                    if constexpr (GA) { if (!P::PREFA || nxt.pm != cur.pm) G_GATHER_A(nxt, P::PREFA); }
                    if constexpr (GB) { G_GATHER_B(nxt); }
                }
            }
            G_LDA(At, 0, 1); G_STAGE_B(G_SB(0, 0), 0, kb); G_STAGE_B(G_SB(0, 1), 1, kb); G_STAGE_A(G_SA(0, 0), 0, kb);
            G_WAIT_V(8); G_WAIT_L(0); G_BAR; G_MMA(1, 0, At, B0); G_MMA(1, 1, At, B1); G_BAR; G_SCHED;
            G_LDB(B0, 1, 0); G_LDB(B1, 1, 1); G_SCHED; G_LDA(At, 1, 0); G_STAGE_A(G_SA(0, 1), 1, kb);
            G_WAIT_V(8); G_WAIT_L(0); G_BAR; G_MMA(0, 0, At, B0); G_MMA(0, 1, At, B1); G_BAR; G_SCHED;
            G_LDA(At, 1, 1); G_STAGE_B(G_SB(1, 0), 0, kb + 1); G_STAGE_B(G_SB(1, 1), 1, kb + 1); G_STAGE_A(G_SA(1, 0), 0, kb + 1);
            G_WAIT_V(8); G_WAIT_L(0); G_BAR; G_MMA(1, 0, At, B0); G_MMA(1, 1, At, B1); G_BAR; G_SCHED;
        }
        if (wr == 0) G_BAR;
        { int tz = threadIdx.x; asm volatile("" : "+v"(tz));
          const int wid2 = tz >> 6, lane2 = tz & 63; p.epi(acc, cur, wid2 >> 2, wid2 & 3, lane2 & 15, lane2 >> 4); }
        if (!has_next) break;
#pragma unroll
        for (int a = 0; a < 2; ++a)
#pragma unroll
            for (int b = 0; b < 2; ++b)
#pragma unroll
                for (int m = 0; m < 4; ++m)
#pragma unroll
                    for (int n = 0; n < 2; ++n) acc[a][b][m][n] = (f32x4){0.f, 0.f, 0.f, 0.f};
        cur = nxt; ++ui;
        if (wr == 1) G_BAR;
    }
    G_WAIT_V(0);
    G_BAR;
#undef G_GATHER_A
#undef G_GATHER_B
#undef G_PREF_A
#undef G_SA
#undef G_SB
#undef G_GLDS
#undef G_STAGE_A
#undef G_STAGE_B
#undef G_LDA
#undef G_LDB
#undef G_MMA
#undef G_CAT
#undef G_WAIT_V
#undef G_WAIT_L
#undef G_BAR
#undef G_SCHED
}
}
using gm::Unit; using gm::Acc;

struct PInM {
    static constexpr bool GA = false, GB = false, PREFA = false, FP8 = false; static constexpr int SCALE_A = 0, SCALE_B = 0, KWRAP = 0; static constexpr int HOOK_KT = 0, K = D, ldA = D, ldB = D, nM = T / 256, nN = 11;
    const bf16_t* A; const bf16_t* B; bf16_t *Q, *Kb, *VT, *GR, *GBt;
    __device__ __forceinline__ const char* tileA(const Unit& u) const { return (const char*)A + (size_t)u.pm * 256 * ldA * 2; }
    __device__ __forceinline__ const char* tileB(const Unit& u) const { return (const char*)B + (size_t)u.pn * 256 * ldB * 2; }
    __device__ __forceinline__ int rowA(const Unit&, int) const { return 0; }
    __device__ __forceinline__ int rowB(const Unit&, int) const { return 0; }
    __device__ __forceinline__ void hook(Acc&, const Unit&, int, int, int, int) const {}
    __device__ __forceinline__ void epi(const Acc& acc, const Unit& u, int wr, int wc, int fr, int fq) const {
        const int row0 = u.pm * 256 + wr * 64 + fr, cw = wc * 32 + 8 * fq;
        if (u.pn < 2) {
#pragma unroll
            for (int ai = 0; ai < 2; ++ai)
#pragma unroll
                for (int m = 0; m < 4; ++m) { bf16_t* rp = Q + (size_t)(row0 + ai * 128 + m * 16) * AW + u.pn * 256 + cw;
#pragma unroll
                    for (int bj = 0; bj < 2; ++bj) *(u32x4*)(rp + bj * 128) = pack8(acc[ai][bj][m][0], acc[ai][bj][m][1]); }
        } else if (u.pn == 2) {
#pragma unroll
            for (int ai = 0; ai < 2; ++ai)
#pragma unroll
                for (int m = 0; m < 4; ++m) { const int row = row0 + ai * 128 + m * 16;
                    *(u32x4*)(Kb + (size_t)row * KVW + cw) = pack8(acc[ai][0][m][0], acc[ai][0][m][1]);
                    const int b = row >> 14, s = row & (SEQ - 1);
#pragma unroll
                    for (int n = 0; n < 2; ++n)
#pragma unroll
                        for (int j = 0; j < 4; ++j) VT[(size_t)(b * KVW + cw + 4 * n + j) * SEQ + s] = (bf16_t)f2bf(acc[ai][1][m][n][j]); }
        } else {
            const int cc = (u.pn - 3) * 128 + cw;
#pragma unroll
            for (int ai = 0; ai < 2; ++ai)
#pragma unroll
                for (int m = 0; m < 4; ++m) { const size_t o = (size_t)(row0 + ai * 128 + m * 16) * D + cc; f32x4 r[2], s[2];
#pragma unroll
                    for (int n = 0; n < 2; ++n)
#pragma unroll
                        for (int j = 0; j < 4; ++j) { const float ta = 1.f + fexp2(fminf(-acc[ai][0][m][n][j], 100.f)), tb = 1.f + fexp2(fminf(-acc[ai][1][m][n][j], 100.f));
                            s[n][j] = frcp(tb); r[n][j] = tb * frcp(ta); }
                    *(u32x4*)(GR + o) = pack8(r[0], r[1]); *(u32x4*)(GBt + o) = pack8(s[0], s[1]); }
        }
    }
};
struct PInF {
    static constexpr bool GA = false, GB = true, PREFA = false, FP8 = false; static constexpr int SCALE_A = 0, SCALE_B = 0, KWRAP = 0; static constexpr int HOOK_KT = 0, K = D, ldA = D, ldB = D, nM = 2, nN = T / 256;
    const bf16_t* A; const bf16_t* B; bf16_t* FT;
    __device__ __forceinline__ const char* tileA(const Unit& u) const { return (const char*)A + (size_t)u.pm * 256 * ldA * 2; }
    __device__ __forceinline__ const char* tileB(const Unit&) const { return (const char*)B; }
    __device__ __forceinline__ int rowA(const Unit&, int) const { return 0; }
    __device__ __forceinline__ int rowB(const Unit& u, int c) const { const int np = u.pn * 256 + c, b = np >> 14, n2 = np & (SEQ - 1); return b * SEQ + (n2 & 127) * 128 + (n2 >> 7); }
    __device__ __forceinline__ void hook(Acc&, const Unit&, int, int, int, int) const {}
    __device__ __forceinline__ void epi(const Acc& acc, const Unit& u, int wr, int wc, int fr, int fq) const {
        const int ch0 = u.pm * 256 + wr * 64 + fr, b = u.pn >> 6, nc = (u.pn & 63) * 256 + wc * 32 + 8 * fq;
#pragma unroll
        for (int ai = 0; ai < 2; ++ai)
#pragma unroll
            for (int m = 0; m < 4; ++m) { bf16_t* rp = FT + (size_t)(b * FW + ch0 + ai * 128 + m * 16) * SEQ + nc;
#pragma unroll
                for (int bj = 0; bj < 2; ++bj) *(u32x4*)(rp + bj * 128) = pack8(acc[ai][bj][m][0], acc[ai][bj][m][1]); }
    }
};
struct PF1 {
    static constexpr bool GA = false, GB = false, PREFA = false, FP8 = false; static constexpr int SCALE_A = 0, SCALE_B = 0, KWRAP = 0; static constexpr int HOOK_KT = 0, K = 128, ldA = 128, ldB = 128, nM = 1, nN = BATCH * FW * 128 / 256;
    const bf16_t* A; const bf16_t* B; bf16_t* QP; const float* twc; const float* tws;
    __device__ __forceinline__ const char* tileA(const Unit&) const { return (const char*)A; }
    __device__ __forceinline__ const char* tileB(const Unit& u) const { return (const char*)B + (size_t)u.pn * 256 * ldB * 2; }
    __device__ __forceinline__ int rowA(const Unit&, int) const { return 0; }
    __device__ __forceinline__ int rowB(const Unit&, int) const { return 0; }
    __device__ __forceinline__ void hook(Acc&, const Unit&, int, int, int, int) const {}
    __device__ __forceinline__ void epi(const Acc& acc, const Unit& u, int wr, int wc, int fr, int fq) const {
        const int cw = wc * 32 + 8 * fq;
        f32x4 c[4][2], s[4][2];
#pragma unroll
        for (int m = 0; m < 4; ++m) { const int klo = wr * 64 + m * 16 + fr;
#pragma unroll
            for (int n = 0; n < 2; ++n) { c[m][n] = *(const f32x4*)(twc + klo * 128 + cw + 4 * n); s[m][n] = *(const f32x4*)(tws + klo * 128 + cw + 4 * n); } }
#pragma unroll
        for (int m = 0; m < 4; ++m) { const int klo = wr * 64 + m * 16 + fr;
#pragma unroll
            for (int bj = 0; bj < 2; ++bj) { f32x4 qr[2], qi[2];
#pragma unroll
                for (int n = 0; n < 2; ++n) { const f32x4 pr = acc[0][bj][m][n], pi = acc[1][bj][m][n]; qr[n] = pr * c[m][n] + pi * s[m][n]; qi[n] = pi * c[m][n] - pr * s[m][n]; }
                bf16_t* rp = QP + ((size_t)((u.pn * 2 + bj) * 128 + klo) * 2) * 128 + cw;
                *(u32x4*)(rp) = pack8(qr[0], qr[1]); *(u32x4*)(rp + 128) = pack8(qi[0], qi[1]); } }
    }
};
struct PF2 {
    static constexpr bool GA = false, GB = true, PREFA = false, FP8 = false; static constexpr int SCALE_A = 0, SCALE_B = 0, KWRAP = 0; static constexpr int HOOK_KT = 0, K = 256, ldA = 256, ldB = 256, nM = 1, nN = 512;
    const bf16_t* A; const bf16_t* B; bf16_t* AH;
    __device__ __forceinline__ const char* tileA(const Unit&) const { return (const char*)A; }
    __device__ __forceinline__ const char* tileB(const Unit&) const { return (const char*)B; }
    __device__ __forceinline__ int rowA(const Unit&, int) const { return 0; }
    __device__ __forceinline__ int rowB(const Unit& u, int c) const { const int b = u.pn >> 8, chq = (u.pn >> 6) & 3, klo = (u.pn & 63) * 2 + (c >> 7), ch = chq * 128 + (c & 127); return (b * FW + ch) * 128 + klo; }
    __device__ __forceinline__ void hook(Acc&, const Unit&, int, int, int, int) const {}
    __device__ __forceinline__ void epi(const Acc& acc, const Unit& u, int wr, int wc, int fr, int fq) const {
        const int b = u.pn >> 8, chq = (u.pn >> 6) & 3, klo0 = (u.pn & 63) * 2, ch = chq * 128 + wc * 32 + 8 * fq;
#pragma unroll
        for (int ai = 0; ai < 2; ++ai)
#pragma unroll
            for (int m = 0; m < 4; ++m) { const int khi = wr * 64 + m * 16 + fr;
#pragma unroll
                for (int bj = 0; bj < 2; ++bj) { const int tok = b * SEQ + 128 * khi + klo0 + bj;
                    *(u32x4*)(AH + (size_t)tok * AHW + 512 + ai * 512 + ch) = pack8(acc[ai][bj][m][0], acc[ai][bj][m][1]); } }
    }
};
struct PMg {
    static constexpr bool GA = false, GB = false, PREFA = false, FP8 = false; static constexpr int SCALE_A = 0, SCALE_B = 0, KWRAP = 0; static constexpr int HOOK_KT = 8, K = AHW, ldA = AHW, ldB = AHW, nM = T / 256, nN = 4;
    const bf16_t* A; const bf16_t* B; const bf16_t* GR; const bf16_t* GBt; bf16_t* MG;
    __device__ __forceinline__ const char* tileA(const Unit& u) const { return (const char*)A + (size_t)u.pm * 256 * ldA * 2; }
    __device__ __forceinline__ const char* tileB(const Unit& u) const { return (const char*)B + (size_t)u.pn * 256 * ldB * 2; }
    __device__ __forceinline__ int rowA(const Unit&, int) const { return 0; }
    __device__ __forceinline__ int rowB(const Unit&, int) const { return 0; }
    __device__ __forceinline__ void hook(Acc& acc, const Unit& u, int wr, int wc, int fr, int fq) const {
        const size_t o0 = (size_t)(u.pm * 256 + wr * 64 + fr) * D + u.pn * 256 + wc * 32 + 8 * fq;
        u32x4 w[2][4][2];
#pragma unroll
        for (int ai = 0; ai < 2; ++ai)
#pragma unroll
            for (int m = 0; m < 4; ++m)
#pragma unroll
                for (int bj = 0; bj < 2; ++bj) w[ai][m][bj] = *(const u32x4*)(GR + o0 + (size_t)(ai * 128 + m * 16) * D + bj * 128);
#pragma unroll
        for (int ai = 0; ai < 2; ++ai)
#pragma unroll
            for (int m = 0; m < 4; ++m)
#pragma unroll
                for (int bj = 0; bj < 2; ++bj) { f32x4 r0, r1; unpack8(w[ai][m][bj], r0, r1); acc[ai][bj][m][0] *= r0; acc[ai][bj][m][1] *= r1; }
    }
    __device__ __forceinline__ void epi(const Acc& acc, const Unit& u, int wr, int wc, int fr, int fq) const {
        const size_t o0 = (size_t)(u.pm * 256 + wr * 64 + fr) * D + u.pn * 256 + wc * 32 + 8 * fq;
        u32x4 w[2][4][2];
#pragma unroll
        for (int ai = 0; ai < 2; ++ai)
#pragma unroll
            for (int m = 0; m < 4; ++m)
#pragma unroll
                for (int bj = 0; bj < 2; ++bj) w[ai][m][bj] = *(const u32x4*)(GBt + o0 + (size_t)(ai * 128 + m * 16) * D + bj * 128);
#pragma unroll
        for (int ai = 0; ai < 2; ++ai)
#pragma unroll
            for (int m = 0; m < 4; ++m)
#pragma unroll
                for (int bj = 0; bj < 2; ++bj) { f32x4 s0, s1; unpack8(w[ai][m][bj], s0, s1);
                    *(u32x4*)(MG + o0 + (size_t)(ai * 128 + m * 16) * D + bj * 128) = pack8(acc[ai][bj][m][0] * s0, acc[ai][bj][m][1] * s1); }
    }
};
struct POut {
    static constexpr bool GA = false, GB = false, PREFA = false, FP8 = false; static constexpr int SCALE_A = 0, SCALE_B = 0, KWRAP = 0; static constexpr int HOOK_KT = 0, K = D, ldA = D, ldB = D, nM = T / 256, nN = 4;
    const bf16_t* A; const bf16_t* B; const float* xin32; bf16_t* xb;
    __device__ __forceinline__ const char* tileA(const Unit& u) const { return (const char*)A + (size_t)u.pm * 256 * ldA * 2; }
    __device__ __forceinline__ const char* tileB(const Unit& u) const { return (const char*)B + (size_t)u.pn * 256 * ldB * 2; }
    __device__ __forceinline__ int rowA(const Unit&, int) const { return 0; }
    __device__ __forceinline__ int rowB(const Unit&, int) const { return 0; }
    __device__ __forceinline__ void hook(Acc&, const Unit&, int, int, int, int) const {}
    __device__ __forceinline__ void epi(const Acc& acc, const Unit& u, int wr, int wc, int fr, int fq) const {
        const size_t o0 = (size_t)(u.pm * 256 + wr * 64 + fr) * D + u.pn * 256 + wc * 32 + 8 * fq;
        if (xin32) {
#pragma unroll
            for (int ai = 0; ai < 2; ++ai) {
                f32x4 xv[4][2][2];
#pragma unroll
                for (int m = 0; m < 4; ++m)
#pragma unroll
                    for (int bj = 0; bj < 2; ++bj) { const size_t o = o0 + (size_t)(ai * 128 + m * 16) * D + bj * 128; xv[m][bj][0] = *(const f32x4*)(xin32 + o); xv[m][bj][1] = *(const f32x4*)(xin32 + o + 4); }
#pragma unroll
                for (int m = 0; m < 4; ++m)
#pragma unroll
                    for (int bj = 0; bj < 2; ++bj) { const size_t o = o0 + (size_t)(ai * 128 + m * 16) * D + bj * 128;
                        *(u32x4*)(xb + o) = pack8(xv[m][bj][0] + acc[ai][bj][m][0], xv[m][bj][1] + acc[ai][bj][m][1]); }
                asm volatile("" ::: "memory");
            }
        } else {
            u32x4 w[2][4][2];
#pragma unroll
            for (int ai = 0; ai < 2; ++ai)
#pragma unroll
                for (int m = 0; m < 4; ++m)
#pragma unroll
                    for (int bj = 0; bj < 2; ++bj) w[ai][m][bj] = *(const u32x4*)(xb + o0 + (size_t)(ai * 128 + m * 16) * D + bj * 128);
#pragma unroll
            for (int ai = 0; ai < 2; ++ai)
#pragma unroll
                for (int m = 0; m < 4; ++m)
#pragma unroll
                    for (int bj = 0; bj < 2; ++bj) { f32x4 x0, x1; unpack8(w[ai][m][bj], x0, x1);
                        *(u32x4*)(xb + o0 + (size_t)(ai * 128 + m * 16) * D + bj * 128) = pack8(x0 + acc[ai][bj][m][0], x1 + acc[ai][bj][m][1]); }
        }
    }
};
constexpr int FK = FFN_FP8 ? 2 : 1;
__device__ __forceinline__ unsigned pk4_fp8(float a, float b, float c, float d) { int r = __builtin_amdgcn_cvt_pk_fp8_f32(a, b, 0, false); r = __builtin_amdgcn_cvt_pk_fp8_f32(c, d, r, true); return (unsigned)r; }
struct PUp {
    static constexpr bool GA = true, GB = false, PREFA = true, FP8 = FFN_FP8 != 0; static constexpr int SCALE_A = 0, SCALE_B = 0, KWRAP = 0;
    static constexpr int HOOK_KT = 0, K = D / FK, ldA = D / FK, ldB = D / FK, nM = NSLOT / 256, nN = 22;
    const bf16_t* A; const bf16_t* B; const int* seltok; bf16_t* ACT;
    __device__ __forceinline__ const char* tileA(const Unit&) const { return (const char*)A; }
    __device__ __forceinline__ const char* tileB(const Unit& u) const { return (const char*)B + (size_t)(u.pm >> 4) * (2 * DFF) * ldB * 2 + (size_t)u.pn * 256 * ldB * 2; }
    __device__ __forceinline__ int rowA(const Unit& u, int r) const { return seltok[u.pm * 256 + r]; }
    __device__ __forceinline__ int rowB(const Unit&, int) const { return 0; }
    __device__ __forceinline__ void hook(Acc&, const Unit&, int, int, int, int) const {}
    __device__ __forceinline__ void epi(const Acc& acc, const Unit& u, int wr, int wc, int fr, int fq) const {
        const int row0 = u.pm * 256 + wr * 64 + fr, cc = u.pn * 128 + wc * 32 + 8 * fq;
#pragma unroll
        for (int ai = 0; ai < 2; ++ai)
#pragma unroll
            for (int m = 0; m < 4; ++m) { f32x4 a[2];
                if constexpr (FP8) {
                    float g8[8], u8[8], e8[8], p8[8];
#pragma unroll
                    for (int i = 0; i < 8; ++i) { g8[i] = acc[ai][0][m][i >> 2][i & 3]; u8[i] = acc[ai][1][m][i >> 2][i & 3]; }
                    mul8_s(e8, -1.f / 64.f, g8);
#pragma unroll
                    for (int i = 0; i < 8; ++i) e8[i] = fexp2(e8[i]);
                    fma8_ss_trans(e8, 4096.f);
#pragma unroll
                    for (int i = 0; i < 8; ++i) e8[i] = frcp(e8[i]);
                    mul8(p8, g8, u8); mul8_trans(p8, e8);
#pragma unroll
                    for (int i = 0; i < 8; ++i) a[i >> 2][i & 3] = __builtin_amdgcn_fmed3f(p8[i], -448.f, 448.f);
                } else {
#pragma unroll
                for (int n = 0; n < 2; ++n)
#pragma unroll
                    for (int j = 0; j < 4; ++j) { const float g = acc[ai][0][m][n][j], up = acc[ai][1][m][n][j];
                        a[n][j] = g * up * frcp(1.f + fexp2(fminf(-g * LOG2E, 80.f))); }
                }
                if constexpr (FP8) { u32x2 w; w.x = pk4_fp8(a[0][0], a[0][1], a[0][2], a[0][3]); w.y = pk4_fp8(a[1][0], a[1][1], a[1][2], a[1][3]);
                    *(u32x2*)((unsigned char*)ACT + (size_t)(row0 + ai * 128 + m * 16) * DFF + cc) = w; }
                else *(u32x4*)(ACT + (size_t)(row0 + ai * 128 + m * 16) * DFF + cc) = pack8(a[0], a[1]); }
    }
};
struct PDn {
    static constexpr bool GA = false, GB = false, PREFA = false, FP8 = FFN_FP8 != 0; static constexpr int SCALE_A = 0, SCALE_B = 0, KWRAP = 0;
    static constexpr int HOOK_KT = 0, K = DFF / FK, ldA = DFF / FK, ldB = DFF / FK, nM = NSLOT / 256, nN = 4;
    const bf16_t* A; const bf16_t* B; const float* selgate; bf16_t* Y;
    __device__ __forceinline__ const char* tileA(const Unit& u) const { return (const char*)A + (size_t)u.pm * 256 * ldA * 2; }
    __device__ __forceinline__ const char* tileB(const Unit& u) const { return (const char*)B + (size_t)(u.pm >> 4) * D * ldB * 2 + (size_t)u.pn * 256 * ldB * 2; }
    __device__ __forceinline__ int rowA(const Unit&, int) const { return 0; }
    __device__ __forceinline__ int rowB(const Unit&, int) const { return 0; }
    __device__ __forceinline__ void hook(Acc&, const Unit&, int, int, int, int) const {}
    __device__ __forceinline__ void epi(const Acc& acc, const Unit& u, int wr, int wc, int fr, int fq) const {
        const int row0 = u.pm * 256 + wr * 64 + fr, cc = u.pn * 256 + wc * 32 + 8 * fq;
#pragma unroll
        for (int ai = 0; ai < 2; ++ai)
#pragma unroll
            for (int m = 0; m < 4; ++m) { const int row = row0 + ai * 128 + m * 16; const float g = selgate[row] * (FP8 ? (1.f / 256.f) : 1.f);
#pragma unroll
                for (int bj = 0; bj < 2; ++bj) *(u32x4*)(Y + (size_t)row * D + cc + bj * 128) = pack8(acc[ai][bj][m][0] * g, acc[ai][bj][m][1] * g); }
    }
};

struct Args { const float* in[14]; float* out; unsigned char* ws; int ph_lo, ph_hi, li, pad; };
struct Frame {
    LAS unsigned char* lds; volatile LAS unsigned* MISC; unsigned* ctl; unsigned char* ws;
    int tid, lane, wave, vcu, G, bid;
};
__device__ __forceinline__ bf16_t* wsb(const Frame& F, size_t off) { return (bf16_t*)(F.ws + off); }

__device__ __forceinline__ void tr_item(const float* src, int ldn, const float* rs, float cs, bf16_t* dptr, int ldd, int lane) {
#pragma unroll 1
    for (int pass = 0; pass < 2; ++pass) {
        f32x4 v[32];
        const float* sp = src + (size_t)(pass * 32) * ldn + 4 * lane;
        float rsl = 1.f; if (rs) rsl = rs[pass * 32 + (lane & 31)];
#pragma unroll
        for (int r = 0; r < 32; ++r) v[r] = __builtin_nontemporal_load((const f32x4*)(sp + (size_t)r * ldn));
#pragma unroll
        for (int r = 0; r < 32; ++r) { const float sc = __builtin_bit_cast(float, __builtin_amdgcn_readlane(__builtin_bit_cast(int, rsl), r)) * cs; v[r] = v[r] * sc; }
#pragma unroll
        for (int j = 0; j < 4; ++j)
#pragma unroll
            for (int c = 0; c < 4; ++c) { u32x4 w; w.x = cvt_pk_bf16(v[8 * c][j], v[8 * c + 1][j]); w.y = cvt_pk_bf16(v[8 * c + 2][j], v[8 * c + 3][j]); w.z = cvt_pk_bf16(v[8 * c + 4][j], v[8 * c + 5][j]); w.w = cvt_pk_bf16(v[8 * c + 6][j], v[8 * c + 7][j]);
                *(u32x4*)(dptr + (size_t)j * ldd + pass * 32 + 8 * c) = w; }
    }
}
__device__ __forceinline__ void tr_item8(const float* src, int ldn, const float* rs, float cs, unsigned char* dst0, int ldd, int hi_stride, int lane, LAS unsigned char* tile) {
#pragma unroll 1
    for (int pass = 0; pass < 2; ++pass) {
        f32x4 v[32];
        const float* sp = src + (size_t)(pass * 32) * ldn + 4 * lane;
#pragma unroll
        for (int r = 0; r < 32; ++r) v[r] = __builtin_nontemporal_load((const f32x4*)(sp + (size_t)r * ldn));
#pragma unroll
        for (int r = 0; r < 32; ++r) { const float sc = rs ? rs[pass * 32 + r] * cs : cs; v[r] = v[r] * sc; }
#pragma unroll
        for (int j = 0; j < 4; ++j)
#pragma unroll
            for (int c = 0; c < 2; ++c) { u32x4 w; w.x = pk4_fp8(v[16 * c][j], v[16 * c + 1][j], v[16 * c + 2][j], v[16 * c + 3][j]); w.y = pk4_fp8(v[16 * c + 4][j], v[16 * c + 5][j], v[16 * c + 6][j], v[16 * c + 7][j]);
                w.z = pk4_fp8(v[16 * c + 8][j], v[16 * c + 9][j], v[16 * c + 10][j], v[16 * c + 11][j]); w.w = pk4_fp8(v[16 * c + 12][j], v[16 * c + 13][j], v[16 * c + 14][j], v[16 * c + 15][j]);
                const int row = 4 * lane + j, ch = 2 * pass + c;
                *(LAS u32x4*)(tile + row * 64 + ((ch ^ (lane & 3)) << 4)) = w; }
    }
    LDS_WAIT(); asm volatile("" ::: "memory");
    int lz = lane; asm volatile("" : "+v"(lz));
#pragma unroll
    for (int i = 0; i < 16; ++i) { const int row = 16 * i + (lz >> 2), ch = lz & 3; const u32x4 w = *(const LAS u32x4*)(tile + row * 64 + ((ch ^ ((row >> 2) & 3)) << 4));
        *(u32x4*)(dst0 + (size_t)((row >> 7) * hi_stride + (row & 127)) * ldd + 16 * ch) = w; if ((i & 3) == 3) asm volatile("" ::: "memory"); }
    LDS_WAIT(); asm volatile("" ::: "memory");
}
__device__ __forceinline__ void tr_item8w(const float* src, int ldn, const float* rs, float cs, unsigned char* dst0, int ldd, int lane, LAS unsigned char* tile) {
    const int h = lane >> 5, l5 = lane & 31;
#pragma unroll 1
    for (int pass = 0; pass < 2; ++pass) {
        f32x4 v[32];
        const float* sp = src + (size_t)(pass * 64 + 32 * h) * ldn + 4 * l5;
        float rsl = 1.f; if (rs) rsl = rs[pass * 64 + lane];
#pragma unroll
        for (int r = 0; r < 32; ++r) v[r] = __builtin_nontemporal_load((const f32x4*)(sp + (size_t)r * ldn));
#pragma unroll
        for (int r = 0; r < 32; ++r) { const float sc = __builtin_bit_cast(float, __builtin_amdgcn_ds_bpermute((32 * h + r) << 2, __builtin_bit_cast(int, rsl))) * cs; v[r] = v[r] * sc; }
#pragma unroll
        for (int j = 0; j < 4; ++j)
#pragma unroll
            for (int c = 0; c < 2; ++c) { u32x4 w; w.x = pk4_fp8(v[16 * c][j], v[16 * c + 1][j], v[16 * c + 2][j], v[16 * c + 3][j]); w.y = pk4_fp8(v[16 * c + 4][j], v[16 * c + 5][j], v[16 * c + 6][j], v[16 * c + 7][j]);
                w.z = pk4_fp8(v[16 * c + 8][j], v[16 * c + 9][j], v[16 * c + 10][j], v[16 * c + 11][j]); w.w = pk4_fp8(v[16 * c + 12][j], v[16 * c + 13][j], v[16 * c + 14][j], v[16 * c + 15][j]);
                const int row = 4 * l5 + j, ch = 4 * pass + 2 * h + c;
                *(LAS u32x4*)(tile + row * 128 + ((ch ^ (l5 & 7)) << 4)) = w; }
    }
    LDS_WAIT(); asm volatile("" ::: "memory");
    int lz = lane; asm volatile("" : "+v"(lz));
#pragma unroll
    for (int i = 0; i < 16; ++i) { const int row = 8 * i + (lz >> 3), ch = lz & 7; const u32x4 w = *(const LAS u32x4*)(tile + row * 128 + ((ch ^ ((row >> 2) & 7)) << 4));
        __builtin_nontemporal_store(w, (u32x4*)(dst0 + (size_t)row * ldd + 16 * ch)); if ((i & 3) == 3) asm volatile("" ::: "memory"); }
    LDS_WAIT(); asm volatile("" ::: "memory");
}
constexpr int EI_G = NE * 16 * 11, EI_DN = NE * 44 * 4, EI_LAYER = 2 * EI_G + EI_DN;
__device__ __forceinline__ void expert_item(const Frame& F, const Args& a, int l, int r, int lane) {
    const float* g_ffn = a.in[8]; const float* w_eg = a.in[10]; const float* w_eu = a.in[11]; const float* w_ed = a.in[12];
    unsigned char* wl = F.ws + WS_W + (size_t)l * W_LAYER;
    if (FFN_FP8) {
        if (r < 2 * EI_G) { const int isu = r >= EI_G; if (isu) r -= EI_G; const int e = r / 176, r2 = r - e * 176, kb = r2 / 22, nb = r2 - kb * 22, k0 = kb * 128;
            tr_item8w((isu ? w_eu : w_eg) + ((size_t)(l * NE + e) * D + k0) * DFF + nb * 128, DFF, g_ffn + l * D + k0, isu ? 64.f * 4.f / LOG2E : 64.f * LOG2E,
                      (unsigned char*)(wl + WO_GU) + ((size_t)e * (2 * DFF) + 512 * (nb >> 1) + 256 * (nb & 1) + 128 * isu) * D + k0, D, lane, F.lds + F.wave * 16384);
        } else { r -= 2 * EI_G; const int e = r / 176, r2 = r - e * 176, kb = r2 >> 3, nb = r2 & 7, k0 = kb * 128;
            tr_item8w(w_ed + ((size_t)(l * NE + e) * DFF + k0) * D + nb * 128, D, nullptr, 64.f, (unsigned char*)(wl + WO_D) + ((size_t)e * D + nb * 128) * DFF + k0, DFF, lane, F.lds + F.wave * 16384); }
        return;
    }
    if (r < 2 * EI_G) { const int isu = r >= EI_G; if (isu) r -= EI_G; const int e = r / (16 * 11), r2 = r - e * (16 * 11), kb = r2 / 11, nb = r2 - kb * 11, n = nb * 256 + 4 * lane, k0 = kb * 64;
        const float* src = (isu ? w_eu : w_eg) + ((size_t)(l * NE + e) * D + k0) * DFF + nb * 256;
        tr_item(src, DFF, g_ffn + l * D + k0, 1.f, (bf16_t*)(wl + WO_GU) + ((size_t)e * (2 * DFF) + 256 * (n >> 7) + 128 * isu + (n & 127)) * D + k0, D, lane);
    } else { r -= 2 * EI_G; const int e = r / (44 * 4), r2 = r - e * (44 * 4), kb = r2 >> 2, nb = r2 & 3, n = nb * 256 + 4 * lane, k0 = kb * 64;
        tr_item(w_ed + ((size_t)(l * NE + e) * DFF + k0) * D + nb * 256, D, nullptr, 1.f, (bf16_t*)(wl + WO_D) + ((size_t)e * D + n) * DFF + k0, DFF, lane); }
}
constexpr int CW_DONE = 8192;
__device__ __forceinline__ void seam_filler(const Frame& F, const Args& a, int k, int need) {
    const int per_layer = (EI_LAYER + F.G - 1) / F.G, total = DEPTH * per_layer;
    volatile LAS int* q = (volatile LAS int*)(F.MISC + 16);
    __syncthreads();
    const int q0 = q[0];
    __syncthreads();
    if (q0 >= total) return;
    if (threadIdx.x == 0) { const unsigned old = __hip_atomic_fetch_add(F.ctl + CW_DONE + 64 * k, 1u, __ATOMIC_RELAXED, __HIP_MEMORY_SCOPE_AGENT); q[1] = (old + 1u == (unsigned)F.G) ? 1 : 0; }
    __syncthreads();
    const int lane = F.lane;
    for (;;) {
        if (q[0] >= need && q[1]) break;
        int it = 0; if (lane == 0) it = __hip_atomic_fetch_add((LAS int*)(F.MISC + 16), 1, __ATOMIC_RELAXED, __HIP_MEMORY_SCOPE_WORKGROUP);
        it = __builtin_amdgcn_readfirstlane(it);
        if (it >= total) break;
        const int l = it / per_layer, loc = it - l * per_layer;
        if (F.vcu * per_layer + loc < EI_LAYER) expert_item(F, a, l, F.vcu * per_layer + loc, lane);
        if (F.wave == 0) { if (__builtin_amdgcn_readfirstlane((int)__hip_atomic_load(F.ctl + CW_DONE + 64 * k, __ATOMIC_RELAXED, __HIP_MEMORY_SCOPE_AGENT)) >= F.G && lane == 0) q[1] = 1; }
    }
}
__device__ __forceinline__ int expert_items_main(int G) { const int total = DEPTH * EI_LAYER, ngw = G * NWAVES, rem = total % ngw; return ((G - BATCH * NE) * NWAVES >= rem && total - rem >= EI_LAYER) ? total - rem : total; }
__device__ __forceinline__ void p0_prologue(const Frame& F, const Args& a) {
    LAS float* cs128 = (LAS float*)(F.lds + RING_BYTES + 4096);
    if (F.tid < 128) { cs128[F.tid] = cospif((float)F.tid / 64.f); cs128[128 + F.tid] = sinpif((float)F.tid / 64.f); }
    __syncthreads();
    const int gw = F.vcu * NWAVES + F.wave, NGW = F.G * NWAVES, lane = F.lane;
    const float* w_in = a.in[3]; const float* g_mix = a.in[2]; const float* w_ap = a.in[5]; const float* w_fp = a.in[6]; const float* w_out = a.in[7];
    const float* g_ffn = a.in[8]; const float* w_router = a.in[9];
    constexpr int I_IN = 16 * 13, I_AP = 8 * 4, I_OUT = 16 * 4;
    constexpr int I_LAYER = I_IN + I_AP + I_OUT;
    for (int it = gw; it < DEPTH * I_LAYER; it += NGW) {
        const int l = it / I_LAYER; int r = it - l * I_LAYER;
        unsigned char* wl = F.ws + WS_W + (size_t)l * W_LAYER;
        if (r < I_IN) { const int kb = r / 13, nb = r - kb * 13, n = nb * 256 + 4 * lane, k0 = kb * 64; bf16_t* dp; float cs = 1.f;
            if (n < 768) { dp = (bf16_t*)(wl + WO_INM) + (size_t)n * D; if (n < 512) cs = 0.125f * LOG2E; }
            else if (n < 1280) dp = (bf16_t*)(wl + WO_F) + (size_t)(n - 768) * D;
            else { const int isb = n >= 2304, c = n - (isb ? 2304 : 1280); dp = (bf16_t*)(wl + WO_INM) + (size_t)(768 + 256 * (c >> 7) + 128 * isb + (c & 127)) * D; cs = LOG2E; }
            tr_item(w_in + (size_t)l * D * INW + (size_t)k0 * INW + nb * 256, INW, g_mix + l * D + k0, cs, dp + k0, D, lane); continue; }
        r -= I_IN;
        if (r < I_AP) { const int kb = r >> 2, nb = r & 3, n = nb * 256 + 4 * lane, k0 = kb * 64;
            tr_item(w_ap + (size_t)l * AW * D + (size_t)k0 * D + nb * 256, D, nullptr, 1.f, (bf16_t*)(wl + WO_MG) + (size_t)n * AHW + k0, AHW, lane); continue; }
        r -= I_AP;
        { const int kb = r >> 2, nb = r & 3, n = nb * 256 + 4 * lane, k0 = kb * 64;
            tr_item(w_out + (size_t)l * D * D + (size_t)k0 * D + nb * 256, D, nullptr, 1.f, (bf16_t*)(wl + WO_OUT) + (size_t)n * D + k0, D, lane); }
    }
    if (MK_N_LAUNCHES != 1 || !USE_FILLER) { const int nmain = expert_items_main(F.G);
        const int nstat = ((nmain / NGW) - QDYN_ROUNDS) * NGW;
        const int nrounds = nstat / NGW, wvi = __builtin_amdgcn_readfirstlane(threadIdx.x) >> 6, fround = wvi < nrounds ? wvi : nrounds;
#pragma unroll 1
        for (int rnd = 0; rnd <= nrounds; ++rnd) {
        int tz_ = threadIdx.x; asm volatile("" : "+v"(tz_)); const int lane_ = tz_ & 63;
        if (rnd == fround) {
            for (int it = gw; it < DEPTH * 4 * 16 * 16; it += NGW) {
                const int l = it >> 10, g = (it >> 8) & 3, n2b = (it >> 4) & 15, nb = it & 15, n = nb * 64 + lane_, n20 = n2b * 8;
                const float* wp = w_fp + (size_t)l * FW * D + (size_t)(g * 128) * D + n;
                float ac[8], as[8];
        #pragma unroll
                for (int i = 0; i < 8; ++i) { ac[i] = 0.f; as[i] = 0.f; }
        #pragma unroll 1
                for (int kh = 0; kh < 128; kh += 32) { float wv[32];
        #pragma unroll
                    for (int q = 0; q < 32; ++q) wv[q] = wp[(size_t)(kh + q) * D];
        #pragma unroll
                    for (int q = 0; q < 32; ++q) { const int k2 = kh + q;
        #pragma unroll
                        for (int i = 0; i < 8; ++i) { const int idx = (k2 * (n20 + i)) & 127; ac[i] += cs128[idx] * wv[q]; as[i] += cs128[128 + idx] * wv[q]; } } }
                const float isq = 0.08838834764831845f;
                bf16_t* dst = (bf16_t*)(F.ws + WS_W + (size_t)l * W_LAYER + WO_MG) + (size_t)n * AHW + 512 + g * 128 + n20;
                u32x4 oc, os; oc.x = pk2(ac[0] * isq, ac[1] * isq); oc.y = pk2(ac[2] * isq, ac[3] * isq); oc.z = pk2(ac[4] * isq, ac[5] * isq); oc.w = pk2(ac[6] * isq, ac[7] * isq);
                os.x = pk2(as[0] * isq, as[1] * isq); os.y = pk2(as[2] * isq, as[3] * isq); os.z = pk2(as[4] * isq, as[5] * isq); os.w = pk2(as[6] * isq, as[7] * isq);
                *(u32x4*)dst = oc; *(u32x4*)(dst + 512) = os;
            }
        }
        if (rnd < nrounds) { const int it = gw + rnd * NGW; expert_item(F, a, it / EI_LAYER, it % EI_LAYER, lane_); }
        }
        unsigned* qc = F.ctl + CW_QEXP;
        int it = 0; if (lane == 0) it = nstat + (int)__hip_atomic_fetch_add(qc, 1u, __ATOMIC_RELAXED, __HIP_MEMORY_SCOPE_AGENT); it = __builtin_amdgcn_readfirstlane(it);
        while (it < nmain) { int nx = 0; if (lane == 0) nx = nstat + (int)__hip_atomic_fetch_add(qc, 1u, __ATOMIC_RELAXED, __HIP_MEMORY_SCOPE_AGENT);
            expert_item(F, a, it / EI_LAYER, it % EI_LAYER, lane); it = __builtin_amdgcn_readfirstlane(nx); } }
    const int gt = (F.vcu * NTHR + F.tid), NGT = F.G * NTHR; const float isq = 0.08838834764831845f;
    bf16_t* F1 = wsb(F, WS_F1); bf16_t* G2 = wsb(F, WS_G2); float* twc = (float*)(F.ws + WS_TWC); float* tws = (float*)(F.ws + WS_TWS); float* wrt = (float*)(F.ws + WS_WRT);
    for (int i = gt; i < 256 * 128; i += NGT) { const int m = i >> 7, k = i & 127, idx = ((m & 127) * k) & 127; const float v = (m < 128) ? cospif((float)idx / 64.f) : -sinpif((float)idx / 64.f); F1[i] = (bf16_t)f2bf(v * isq); }
    for (int i = gt; i < 256 * 256; i += NGT) { const int m = i >> 8, k = i & 255, ro = m >> 7, ri = k >> 7, idx = ((m & 127) * (k & 127)) & 127; const float c = cospif((float)idx / 64.f), s = sinpif((float)idx / 64.f);
        const float v = (ro == ri) ? c : (ro == 0 ? s : -s); G2[i] = (bf16_t)f2bf(v * isq); }
    for (int i = gt; i < 128 * 128; i += NGT) { const int klo = i >> 7, nlo = i & 127; const float ang = (float)(klo * nlo) / 8192.f; twc[i] = cospif(ang); tws[i] = sinpif(ang); }
    for (int i = gt; i < DEPTH * NE * D; i += NGT) { const int l = i / (NE * D), e = (i / D) % NE, d = i % D; wrt[i] = g_ffn[l * D + d] * w_router[((size_t)l * D + d) * NE + e]; }
}

template <bool SRC32> __device__ __forceinline__ void rp1_load(f32x4 (&d)[4], const float* xsrc32, const bf16_t* xb, int row, int lane) {
    if constexpr (SRC32) {
#pragma unroll
        for (int j = 0; j < 4; ++j) d[j] = *(const f32x4*)(xsrc32 + (size_t)row * D + 4 * lane + 256 * j);
    } else {
#pragma unroll
        for (int j = 0; j < 4; ++j) { const u32x2 w = *(const u32x2*)(xb + (size_t)row * D + 4 * lane + 256 * j); d[j][0] = bflo(w.x); d[j][1] = bfhi(w.x); d[j][2] = bflo(w.y); d[j][3] = bfhi(w.y); }
    }
}
template <bool COMBINE, bool STORE_X, bool FINAL, bool SRC32>
__device__ __forceinline__ void rp1(const Frame& F, const float* xsrc32, float* out32, bf16_t* h, const float* gfin) {
    const int gw = F.vcu * NWAVES + F.wave, NGW = F.G * NWAVES, lane = F.lane;
    const int* slot = (const int*)(F.ws + WS_SLOT); const bf16_t* Y = wsb(F, WS_Y); bf16_t* xb = wsb(F, WS_XB);
    constexpr int R = COMBINE ? 2 : 4;
    int m = gw; f32x4 v[R][4]; int sl[R];
#pragma unroll
    for (int r = 0; r < R; ++r) { sl[r] = -1; if (m + r * NGW < T) { rp1_load<SRC32>(v[r], xsrc32, xb, m + r * NGW, lane); if (COMBINE && lane < NE) sl[r] = slot[(m + r * NGW) * NE + lane]; } }
    for (; m < T; m += R * NGW) {
        const int mn = m + R * NGW; f32x4 nv[R][4]; int nsl[R];
#pragma unroll
        for (int r = 0; r < R; ++r) { nsl[r] = -1; if (mn + r * NGW < T) { rp1_load<SRC32>(nv[r], xsrc32, xb, mn + r * NGW, lane); if (COMBINE && lane < NE) nsl[r] = slot[(mn + r * NGW) * NE + lane]; } }
        if constexpr (COMBINE) {
            unsigned mk[R];
#pragma unroll
            for (int r = 0; r < R; ++r) mk[r] = (unsigned)__ballot(sl[r] >= 0);
            while (mk[0] | mk[R - 1]) {
                u32x2 y[R][2][4]; bool has[R][2];
#pragma unroll
                for (int r = 0; r < R; ++r)
#pragma unroll
                    for (int t = 0; t < 2; ++t) { has[r][t] = mk[r] != 0;
                        if (has[r][t]) { const int e = __builtin_ctz(mk[r]); mk[r] &= mk[r] - 1; const int sr = __builtin_amdgcn_readlane(sl[r], e);
#pragma unroll
                            for (int j = 0; j < 4; ++j) y[r][t][j] = *(const u32x2*)(Y + (size_t)sr * D + 4 * lane + 256 * j); } }
#pragma unroll
                for (int r = 0; r < R; ++r)
#pragma unroll
                    for (int t = 0; t < 2; ++t) if (has[r][t]) {
#pragma unroll
                        for (int j = 0; j < 4; ++j) { v[r][j][0] += bflo(y[r][t][j].x); v[r][j][1] += bfhi(y[r][t][j].x); v[r][j][2] += bflo(y[r][t][j].y); v[r][j][3] += bfhi(y[r][t][j].y); } }
            }
        }
#pragma unroll
        for (int r = 0; r < R; ++r) {
            const int mr = m + r * NGW;
            float ss = 0.f;
#pragma unroll
            for (int j = 0; j < 4; ++j) ss += (v[r][j][0] * v[r][j][0] + v[r][j][1] * v[r][j][1]) + (v[r][j][2] * v[r][j][2] + v[r][j][3] * v[r][j][3]);
            const float rstd = 1.0f / sqrtf(wave_sum(ss) * (1.f / D) + EPS);
            if (mr < T) {
                if constexpr (FINAL) {
#pragma unroll
                    for (int j = 0; j < 4; ++j) { const f32x4 g = *(const f32x4*)(gfin + 4 * lane + 256 * j); *(f32x4*)(out32 + (size_t)mr * D + 4 * lane + 256 * j) = v[r][j] * rstd * g; }
                } else {
                    if constexpr (STORE_X) {
#pragma unroll
                        for (int j = 0; j < 4; ++j) { u32x2 w; w.x = cvt_pk_bf16(v[r][j][0], v[r][j][1]); w.y = cvt_pk_bf16(v[r][j][2], v[r][j][3]); *(u32x2*)(xb + (size_t)mr * D + 4 * lane + 256 * j) = w; }
                    }
#pragma unroll
                    for (int j = 0; j < 4; ++j) { u32x2 w; w.x = cvt_pk_bf16(v[r][j][0] * rstd, v[r][j][1] * rstd); w.y = cvt_pk_bf16(v[r][j][2] * rstd, v[r][j][3] * rstd); *(u32x2*)(h + (size_t)mr * D + 4 * lane + 256 * j) = w; }
                }
            }
        }
#pragma unroll
        for (int r = 0; r < R; ++r) { sl[r] = nsl[r];
#pragma unroll
            for (int j = 0; j < 4; ++j) v[r][j] = nv[r][j]; }
    }
}
constexpr int RW_PITCH = D + 8;
__device__ __forceinline__ void rp2_mfma(const Frame& F, bf16_t* h, int layer) {
    const int lane = F.lane, r = lane & 15, g = lane >> 4;
    LAS bf16_t* whi = (LAS bf16_t*)F.lds; LAS bf16_t* wlo = whi + NE * RW_PITCH;
    const float* wrt = (const float*)(F.ws + WS_WRT) + (size_t)layer * NE * D;
    { f32x4 w4[NE * D / (4 * NTHR)];
#pragma unroll
        for (int j = 0; j < NE * D / (4 * NTHR); ++j) w4[j] = *(const f32x4*)(wrt + 4 * F.tid + 4 * NTHR * j);
#pragma unroll
        for (int j = 0; j < NE * D / (4 * NTHR); ++j) { const int i = 4 * F.tid + 4 * NTHR * j, e = i >> 10, k = i & (D - 1); unsigned hb[4], lb[4];
#pragma unroll
            for (int q = 0; q < 4; ++q) { hb[q] = f2bf(w4[j][q]) & 0xffffu; lb[q] = f2bf(w4[j][q] - __builtin_bit_cast(float, hb[q] << 16)) & 0xffffu; }
            u32x2 hv, lv; hv.x = hb[0] | (hb[1] << 16); hv.y = hb[2] | (hb[3] << 16); lv.x = lb[0] | (lb[1] << 16); lv.y = lb[2] | (lb[3] << 16);
            *(LAS u32x2*)(whi + e * RW_PITCH + k) = hv; *(LAS u32x2*)(wlo + e * RW_PITCH + k) = lv; } }
    __syncthreads();
    const bf16_t* xb = wsb(F, WS_XB); float* aff = (float*)(F.ws + WS_AFF); int* slot = (int*)(F.ws + WS_SLOT);
    const int nblk = T / 16, gw = F.vcu * NWAVES + F.wave, NGW = F.G * NWAVES;
    for (int blk = gw; blk < nblk; blk += NGW) {
        const int row0 = blk * 16;
        bf16x8 xa[32];
        const bf16_t* xp = xb + (size_t)(row0 + r) * D + 8 * g; unsigned char* hp = (unsigned char*)h + (size_t)(row0 + r) * D + 8 * g;
#pragma unroll
        for (int ks = 0; ks < 32; ++ks) xa[ks] = *(const bf16x8*)(xp + 32 * ks);
        f32x4 acc = (f32x4){0.f, 0.f, 0.f, 0.f}; float ss = 0.f; const LAS bf16_t* wfh = whi + r * RW_PITCH + 8 * g;
#pragma unroll
        for (int ks = 0; ks < 32; ++ks) {
            const bf16x8 bh = *(const LAS bf16x8*)(wfh + 32 * ks), bl = *(const LAS bf16x8*)(wfh + NE * RW_PITCH + 32 * ks);
            acc = __builtin_amdgcn_mfma_f32_16x16x32_bf16(xa[ks], bh, acc, 0, 0, 0);
            acc = __builtin_amdgcn_mfma_f32_16x16x32_bf16(xa[ks], bl, acc, 0, 0, 0);
            const u32x4 w = __builtin_bit_cast(u32x4, xa[ks]);
            const float x0 = bflo(w.x), x1 = bfhi(w.x), x2 = bflo(w.y), x3 = bfhi(w.y), x4 = bflo(w.z), x5 = bfhi(w.z), x6 = bflo(w.w), x7 = bfhi(w.w);
            ss += ((x0 * x0 + x1 * x1) + (x2 * x2 + x3 * x3)) + ((x4 * x4 + x5 * x5) + (x6 * x6 + x7 * x7));
            if ((ks & 3) == 3) asm volatile("" : "+v"(acc), "+v"(ss) :: "memory");
        }
        ss = x16_sum(ss); ss = x32_sum(ss);
        const float rstd = 1.0f / sqrtf(ss * (1.f / D) + EPS);
#pragma unroll
        for (int ks = 0; ks < 32; ++ks) { u32x4 w = __builtin_bit_cast(u32x4, xa[ks]); asm volatile("" : "+v"(w)); u32x2 o;
            o.x = pk4_fp8(bflo(w.x) * rstd, bfhi(w.x) * rstd, bflo(w.y) * rstd, bfhi(w.y) * rstd); o.y = pk4_fp8(bflo(w.z) * rstd, bfhi(w.z) * rstd, bflo(w.w) * rstd, bfhi(w.w) * rstd);
            *(u32x2*)(hp + 32 * ks) = o; if ((ks & 3) == 3) asm volatile("" ::: "memory"); }
#pragma unroll
        for (int reg = 0; reg < 4; ++reg) {
            const float rs = __builtin_bit_cast(float, __builtin_amdgcn_ds_bpermute((4 * g + reg) << 2, __builtin_bit_cast(int, rstd)));
            const float lg = acc[reg] * rs;
            float mx = lg; mx = fmaxf(mx, dpp_mov<0xB1>(mx)); mx = fmaxf(mx, dpp_mov<0x4E>(mx)); mx = fmaxf(mx, dpp_mov<0x141>(mx)); mx = fmaxf(mx, dpp_mov<0x140>(mx));
            const float ex = expf(lg - mx); float den = ex; den += dpp_mov<0xB1>(den); den += dpp_mov<0x4E>(den); den += dpp_mov<0x141>(den); den += dpp_mov<0x140>(den);
            const int mr = row0 + 4 * g + reg, b = mr >> 14, sq = mr & (SEQ - 1);
            aff[(size_t)(b * NE + r) * SEQ + sq] = ex / den; slot[mr * NE + r] = -1;
        }
    }
    __syncthreads();
}
__device__ __forceinline__ void rp2(const Frame& F, bf16_t* h, int layer) {
    const bf16_t* xb = wsb(F, WS_XB);
    const int gw = F.vcu * NWAVES + F.wave, NGW = F.G * NWAVES, lane = F.lane;
    LAS float* wl = (LAS float*)F.lds;
    const float* wrt = (const float*)(F.ws + WS_WRT) + (size_t)layer * NE * D;
    for (int i = F.tid; i < NE * D / 4; i += NTHR) ((LAS f32x4*)wl)[i] = ((const f32x4*)wrt)[i];
    __syncthreads();
    float* aff = (float*)(F.ws + WS_AFF); int* slot = (int*)(F.ws + WS_SLOT);
    constexpr int R = 2;
    int m = gw; f32x4 v[R][4];
#pragma unroll
    for (int r = 0; r < R; ++r) if (m + r * NGW < T) {
        rp1_load<false>(v[r], nullptr, xb, m + r * NGW, lane);
    }
    for (; m < T; m += R * NGW) {
        const int mn = m + R * NGW; f32x4 nv[R][4];
#pragma unroll
        for (int r = 0; r < R; ++r) if (mn + r * NGW < T) rp1_load<false>(nv[r], nullptr, xb, mn + r * NGW, lane);
        float rstd[R];
#pragma unroll
        for (int r = 0; r < R; ++r) { float ss = 0.f;
#pragma unroll
            for (int j = 0; j < 4; ++j) ss += (v[r][j][0] * v[r][j][0] + v[r][j][1] * v[r][j][1]) + (v[r][j][2] * v[r][j][2] + v[r][j][3] * v[r][j][3]);
            rstd[r] = 1.0f / sqrtf(wave_sum(ss) * (1.f / D) + EPS); }
#pragma unroll
        for (int r = 0; r < R; ++r) if (m + r * NGW < T) {
#pragma unroll
            for (int j = 0; j < 4; ++j) { const size_t o = (size_t)(m + r * NGW) * D + 4 * lane + 256 * j;
                if (FFN_FP8) *(unsigned*)((unsigned char*)h + o) = pk4_fp8(v[r][j][0] * rstd[r], v[r][j][1] * rstd[r], v[r][j][2] * rstd[r], v[r][j][3] * rstd[r]);
                else { u32x2 w; w.x = cvt_pk_bf16(v[r][j][0] * rstd[r], v[r][j][1] * rstd[r]); w.y = cvt_pk_bf16(v[r][j][2] * rstd[r], v[r][j][3] * rstd[r]); *(u32x2*)(h + o) = w; } }
        }
        float pr[R][NE];
        f32x4 wc[4], wn[4];
#pragma unroll
        for (int j = 0; j < 4; ++j) wc[j] = *(const LAS f32x4*)(wl + 4 * lane + 256 * j);
#pragma unroll
        for (int e = 0; e < NE; ++e) {
            if (e + 1 < NE) {
#pragma unroll
                for (int j = 0; j < 4; ++j) wn[j] = *(const LAS f32x4*)(wl + (e + 1) * D + 4 * lane + 256 * j);
            }
            asm volatile("" ::: "memory");
#pragma unroll
            for (int r = 0; r < R; ++r) { float sacc = 0.f;
#pragma unroll
                for (int j = 0; j < 4; ++j) sacc += (v[r][j][0] * wc[j][0] + v[r][j][1] * wc[j][1]) + (v[r][j][2] * wc[j][2] + v[r][j][3] * wc[j][3]);
                pr[r][e] = sacc; }
            asm volatile("" : "+v"(pr[0][e]), "+v"(pr[1][e]) :: "memory");
#pragma unroll
            for (int j = 0; j < 4; ++j) wc[j] = wn[j];
        }
#pragma unroll
        for (int r = 0; r < R; ++r) {
            float p8[8], p4[4], p2[2], p1;
            { const bool up = (lane & 32) != 0;
#pragma unroll
              for (int i = 0; i < 8; ++i) { const float keep = up ? pr[r][8 + i] : pr[r][i], send = up ? pr[r][i] : pr[r][8 + i]; p8[i] = keep + x32_get(send, up); } }
            { const bool up = (lane & 16) != 0;
#pragma unroll
              for (int i = 0; i < 4; ++i) { const float keep = up ? p8[4 + i] : p8[i], send = up ? p8[i] : p8[4 + i]; p4[i] = keep + x16_get(send, up); } }
            { const bool up = (lane & 8) != 0;
#pragma unroll
              for (int i = 0; i < 2; ++i) { const float keep = up ? p4[2 + i] : p4[i], send = up ? p4[i] : p4[2 + i]; p2[i] = keep + swz_xor<8>(send); } }
            { const bool up = (lane & 4) != 0; const float keep = up ? p2[1] : p2[0], send = up ? p2[0] : p2[1]; p1 = keep + swz_xor<4>(send); }
            p1 += swz_xor<2>(p1); p1 += swz_xor<1>(p1);
            const float lg = p1 * rstd[r]; const int ex_e = ((lane >> 5) & 1) * 8 + ((lane >> 4) & 1) * 4 + ((lane >> 3) & 1) * 2 + ((lane >> 2) & 1);
            float mx = lg; mx = fmaxf(mx, swz_xor<4>(mx)); mx = fmaxf(mx, swz_xor<8>(mx)); mx = x16_max(mx); mx = x32_max(mx);
            const float ex = expf(lg - mx); float den = ex; den += swz_xor<4>(den); den += swz_xor<8>(den); den = x16_sum(den); den = x32_sum(den);
            const int mr = m + r * NGW;
            if ((lane & 3) == 0 && mr < T) { const int b = mr >> 14, sq = mr & (SEQ - 1); aff[(size_t)(b * NE + ex_e) * SEQ + sq] = ex / den; slot[mr * NE + ex_e] = -1; }
        }
#pragma unroll
        for (int r = 0; r < R; ++r)
#pragma unroll
            for (int j = 0; j < 4; ++j) v[r][j] = nv[r][j];
    }
    __syncthreads();
}
__device__ __forceinline__ void topk_phase(const Frame& F, const Args& args_, int layer) {
    if (F.bid >= BATCH * NE) {
        if (layer == 0) { const int it = expert_items_main(F.G) + (F.bid - BATCH * NE) * NWAVES + F.wave; if (it < DEPTH * EI_LAYER) expert_item(F, args_, it / EI_LAYER, it % EI_LAYER, F.lane); }
        return;
    }
    const int e = F.bid >> 1, b = F.bid & 1, tid = F.tid, lane = F.lane, wave = F.wave;
    const unsigned* a = (const unsigned*)(F.ws + WS_AFF) + (size_t)(b * NE + e) * SEQ;
    LAS int* red = (LAS int*)F.lds;
    unsigned v[32];
#pragma unroll
    for (int j = 0; j < 8; ++j) { const u32x4 w = *(const u32x4*)(a + 32 * tid + 4 * j); v[4 * j] = w.x; v[4 * j + 1] = w.y; v[4 * j + 2] = w.z; v[4 * j + 3] = w.w; }
    unsigned Tv = 0u; int it = 0;
    for (int bit = 30; bit >= 0; --bit, ++it) {
        const unsigned cand = Tv | (1u << bit); int c = 0;
#pragma unroll
        for (int j = 0; j < 32; ++j) c += (v[j] >= cand) ? 1 : 0;
        c = wave_sum_i(c);
        LAS int* slot = red + (it & 1) * 8;
        if (lane == 0) slot[wave] = c;
        __syncthreads();
        int tot = 0;
#pragma unroll
        for (int w = 0; w < 8; ++w) tot += slot[w];
        if (tot >= CAP) Tv = cand;
    }
    __syncthreads();
    int cg = 0, ce = 0;
#pragma unroll
    for (int j = 0; j < 32; ++j) { cg += (v[j] > Tv) ? 1 : 0; ce += (v[j] == Tv) ? 1 : 0; }
    int sg = cg, se = ce;
#pragma unroll
    for (int o = 1; o < 64; o <<= 1) { const int src = ((lane >= o ? lane - o : lane) << 2); const int tg = __builtin_amdgcn_ds_bpermute(src, sg), te = __builtin_amdgcn_ds_bpermute(src, se); if (lane >= o) { sg += tg; se += te; } }
    LAS int* wtot = red + 16;
    if (lane == 63) { wtot[wave] = sg; wtot[8 + wave] = se; }
    __syncthreads();
    int bg = 0, be = 0, totg = 0;
#pragma unroll
    for (int w = 0; w < 8; ++w) { const int xg = wtot[w], xe = wtot[8 + w]; if (w < wave) { bg += xg; be += xe; } totg += xg; }
    int pg = bg + sg - cg, pe = be + se - ce;
    const int need = CAP - totg;
    const int slotbase = (e * BATCH + b) * CAP;
    int* seltok = (int*)(F.ws + WS_SELTOK); float* selgate = (float*)(F.ws + WS_SELGATE); int* slot = (int*)(F.ws + WS_SLOT);
#pragma unroll
    for (int j = 0; j < 32; ++j) {
        const bool isg = v[j] > Tv, ise = v[j] == Tv;
        const bool sel = isg || (ise && pe < need);
        if (sel) { const int pos = slotbase + pg + (pe < need ? pe : need); const int tok = b * SEQ + 32 * tid + j;
            seltok[pos] = tok; selgate[pos] = __builtin_bit_cast(float, v[j]); slot[tok * NE + e] = pos; }
        pg += isg ? 1 : 0; pe += ise ? 1 : 0;
    }
}

constexpr int AT_K = 0, AT_VT = 49152, AT_VPITCH = 776, AT_TAB = AT_VT + 64 * AT_VPITCH, AT_END = AT_TAB + 4 * 512 * 4;
static_assert(AT_END <= RING_BYTES && (AT_TAB % 16) == 0, "attention LDS");
__device__ __forceinline__ int crow(int r, int hi) { return (r & 3) + 8 * (r >> 2) + 4 * hi; }
__device__ __forceinline__ int t5_bucket(int rel) {
    const int n = rel < 0 ? -rel : rel; const int ret = rel > 0 ? 16 : 0;
    if (n < 8) return ret + n;
    int lg = 8 + (n >= 12) + (n >= 16) + (n >= 23) + (n >= 32) + (n >= 46) + (n >= 64) + (n >= 91);
    return ret + lg;
}
__device__ __forceinline__ void attn_phase(const Frame& F, const bf16_t* Q, const bf16_t* Kb, const bf16_t* VT, bf16_t* AH, const float* rel_bias, const float* sink) {
    LAS unsigned char* lds = F.lds; const int tid = F.tid, lane = F.lane, wave = F.wave;
    LAS float* TAB = (LAS float*)(lds + AT_TAB);
    for (int ui = F.vcu; ui < BATCH * 128 * 2; ui += F.G) {
        const int kvh = ui & 1, nb = (ui >> 1) & 127, b = ui >> 8;
        const int s0 = 128 * nb - 128;
        __syncthreads();
#pragma unroll
        for (int i = 0; i < 6; ++i) { const int id = tid + 512 * i, row = id >> 3, ch = id & 7, s = s0 + row;
            u32x4 w = (u32x4){0u, 0u, 0u, 0u}; if (s >= 0 && s < SEQ) w = *(const u32x4*)(Kb + (size_t)(b * SEQ + s) * KVW + kvh * 64 + ch * 8);
            *(LAS u32x4*)(lds + AT_K + row * 128 + ((ch ^ (row & 7)) << 4)) = w; }
#pragma unroll
        for (int i = 0; i < 6; ++i) { const int id = tid + 512 * i, d = id / 48, ch = id - d * 48, s = s0 + 8 * ch;
            u32x4 w = (u32x4){0u, 0u, 0u, 0u}; if (s >= 0 && s < SEQ) w = *(const u32x4*)(VT + (size_t)(b * KVW + kvh * 64 + d) * SEQ + s);
            LAS u32x2* dp = (LAS u32x2*)(lds + AT_VT + d * AT_VPITCH + ch * 16); dp[0] = (u32x2){w.x, w.y}; dp[1] = (u32x2){w.z, w.w}; }
#pragma unroll
        for (int g = 0; g < 4; ++g) { const int rel = tid - 256; TAB[g * 512 + tid] = (rel >= -128 && rel <= 128) ? rel_bias[t5_bucket(rel) * NH + kvh * 4 + g] * LOG2E : -1.0e30f; }
        __syncthreads();
        const int g = wave >> 1, h = kvh * 4 + g, q = lane & 31, hh = lane >> 5;
        const float sk = sink[h] * LOG2E;
        for (int qb = 0; qb < 2; ++qb) {
            const int qoff = (wave & 1) * 64 + qb * 32, qloc = qoff + q; const size_t tok = (size_t)b * SEQ + 128 * nb + qloc;
            bf16x8 qf[4];
#pragma unroll
            for (int ks = 0; ks < 4; ++ks) qf[ks] = *(const bf16x8*)(Q + tok * AW + h * 64 + 16 * ks + 8 * hh);
            float mrun = sk, lrun = 1.f; f32x16 O0, O1;
#pragma unroll
            for (int r = 0; r < 16; ++r) { O0[r] = 0.f; O1[r] = 0.f; }
            int tlo = qoff >> 5, thi = tlo + 8; if (nb == 0 && tlo < 4) tlo = 4; if (nb == 127 && thi > 7) thi = 7;
            const LAS float* tb = TAB + g * 512 + 128 - qloc;
            for (int t = tlo; t <= thi; ++t) {
                f32x16 S;
#pragma unroll
                for (int r = 0; r < 16; ++r) S[r] = tb[32 * t + crow(r, hh)];
                const int krow = 32 * t + q;
#pragma unroll
                for (int ks = 0; ks < 4; ++ks) { const bf16x8 kf = *(const LAS bf16x8*)(lds + AT_K + krow * 128 + (((2 * ks + hh) ^ (krow & 7)) << 4));
                    S = __builtin_amdgcn_mfma_f32_32x32x16_bf16(kf, qf[ks], S, 0, 0, 0); }
                float tmax = -3.0e38f;
#pragma unroll
                for (int r = 0; r < 16; ++r) tmax = fmaxf(tmax, S[r]);
                tmax = x32_max(tmax);
                const float mnew = fmaxf(mrun, tmax), alpha = fexp2(mrun - mnew); mrun = mnew;
                float ps = 0.f;
#pragma unroll
                for (int r = 0; r < 16; ++r) { S[r] = fexp2(S[r] - mnew); ps += S[r]; }
                ps = x32_sum(ps);
                lrun = lrun * alpha + ps;
#pragma unroll
                for (int r = 0; r < 16; ++r) { O0[r] *= alpha; O1[r] *= alpha; }
                u32x4 p0, p1;
                p0.x = cvt_pk_bf16(S[0], S[1]); p0.y = cvt_pk_bf16(S[2], S[3]); p0.z = cvt_pk_bf16(S[4], S[5]); p0.w = cvt_pk_bf16(S[6], S[7]);
                p1.x = cvt_pk_bf16(S[8], S[9]); p1.y = cvt_pk_bf16(S[10], S[11]); p1.z = cvt_pk_bf16(S[12], S[13]); p1.w = cvt_pk_bf16(S[14], S[15]);
                const bf16x8 pf0 = __builtin_bit_cast(bf16x8, p0), pf1 = __builtin_bit_cast(bf16x8, p1);
#pragma unroll
                for (int s = 0; s < 2; ++s) {
                    const int kofs = (32 * t + 16 * s + 4 * hh) * 2;
                    const LAS unsigned char* v0 = lds + AT_VT + q * AT_VPITCH + kofs; const LAS unsigned char* v1 = v0 + 32 * AT_VPITCH;
                    const u32x2 a0 = *(const LAS u32x2*)(v0), a1 = *(const LAS u32x2*)(v0 + 16), c0 = *(const LAS u32x2*)(v1), c1 = *(const LAS u32x2*)(v1 + 16);
                    const bf16x8 vf0 = __builtin_bit_cast(bf16x8, (u32x4){a0.x, a0.y, a1.x, a1.y}), vf1 = __builtin_bit_cast(bf16x8, (u32x4){c0.x, c0.y, c1.x, c1.y});
                    O0 = __builtin_amdgcn_mfma_f32_32x32x16_bf16(vf0, s == 0 ? pf0 : pf1, O0, 0, 0, 0);
                    O1 = __builtin_amdgcn_mfma_f32_32x32x16_bf16(vf1, s == 0 ? pf0 : pf1, O1, 0, 0, 0);
                }
            }
            const float inv = 1.0f / lrun;
            bf16_t* op = AH + tok * AHW + h * 64 + 4 * hh;
#pragma unroll
            for (int r4 = 0; r4 < 4; ++r4) {
                u32x2 w0, w1; w0.x = cvt_pk_bf16(O0[4 * r4] * inv, O0[4 * r4 + 1] * inv); w0.y = cvt_pk_bf16(O0[4 * r4 + 2] * inv, O0[4 * r4 + 3] * inv);
                w1.x = cvt_pk_bf16(O1[4 * r4] * inv, O1[4 * r4 + 1] * inv); w1.y = cvt_pk_bf16(O1[4 * r4 + 2] * inv, O1[4 * r4 + 3] * inv);
                *(u32x2*)(op + 8 * r4) = w0; *(u32x2*)(op + 32 + 8 * r4) = w1; }
        }
    }
    __syncthreads();
}

__device__ __forceinline__ bool in_range(int k, int lo, int hi) { asm volatile("" : "+s"(lo), "+s"(hi)); return lo <= k && k < hi; }
constexpr int PH_PER_LAYER = 10, N_PHASES = 1 + DEPTH * PH_PER_LAYER + 1;
__global__ void __launch_bounds__(NTHR, 2) mk_fwd(Args args) {
    extern __shared__ __attribute__((aligned(16))) unsigned char lds_raw[];
    Frame F;
    F.lds = (LAS unsigned char*)lds_raw; F.MISC = (volatile LAS unsigned*)(F.lds + MISC_OFF);
    F.tid = threadIdx.x; F.lane = F.tid & 63; F.wave = __builtin_amdgcn_readfirstlane(F.tid >> 6);
    F.G = gridDim.x; F.bid = blockIdx.x; F.vcu = F.bid;
    F.ws = args.ws; F.ctl = (unsigned*)(args.ws + WS_CTL);
    for (int u = F.tid; u < (LDS_BYTES - RING_BYTES) / 4; u += NTHR) ((LAS unsigned*)(F.lds + RING_BYTES))[u] = 0u;
    __syncthreads();
    if (MK_N_LAUNCHES == 1) (void)xcd_barrier_post(F.ctl + CW_BAR, F.MISC + 8);
    if (PROBE_MODE && threadIdx.x == 0) { volatile LAS unsigned long long* ps = (volatile LAS unsigned long long*)(F.lds + RING_BYTES + 1024); ps[0] = 0; ps[1] = 0; ps[2] = __builtin_amdgcn_s_memrealtime(); }
    const int lo = args.ph_lo, hi = args.ph_hi;
#if MK_N_LAUNCHES == 1
#define IN(k) true
#else
#define IN(k) in_range((k), lo, hi)
#endif
#define PHASE_BEGIN() do { int _tz = threadIdx.x; asm volatile("" : "+v"(_tz)); F.tid = _tz; F.lane = _tz & 63; size_t _z = 0; int _g = gridDim.x, _b = blockIdx.x; asm volatile("" : "+s"(_z), "+s"(_g), "+s"(_b)); F.ws = args.ws + _z; F.G = _g; F.bid = _b; F.vcu = (_g % 8 == 0) ? (_b % 8) * (_g / 8) + _b / 8 : _b; } while (0)
#define SEAM(k) do { if (IN(k) && IN((k) + 1)) { if (USE_FILLER && MK_N_LAUNCHES == 1 && (k) <= 18) { PHASE_BEGIN(); const int _pl = (EI_LAYER + F.G - 1) / F.G; seam_filler(F, args, (k), (k) >= 18 ? 2 * _pl : ((k) >= 8 ? _pl : 0)); } XcdBarrier _b; _b.bar = (unsigned*)(args.ws + WS_CTL) + CW_BAR; _b.x = 0; _b.st = F.MISC + 8; \
        unsigned long long _t0 = 0; if (PROBE_MODE == 2 && threadIdx.x == 0) _t0 = __builtin_amdgcn_s_memrealtime(); \
        if (PROBE_MODE == 3 && threadIdx.x == 0 && (k) == PROBE_K) { volatile LAS unsigned long long* _ps = (volatile LAS unsigned long long*)(F.lds + RING_BYTES + 1024); _ps[5] = __builtin_amdgcn_s_memtime(); _ps[6] = __builtin_amdgcn_s_memrealtime(); } \
        xcd_barrier(_b); \
        if (PROBE_MODE == 3 && threadIdx.x == 0 && (k) == PROBE_K - 1) { volatile LAS unsigned long long* _ps = (volatile LAS unsigned long long*)(F.lds + RING_BYTES + 1024); _ps[3] = __builtin_amdgcn_s_memtime(); _ps[4] = __builtin_amdgcn_s_memrealtime(); } \
        if (PROBE_MODE && threadIdx.x == 0) { const unsigned long long _t1 = __builtin_amdgcn_s_memrealtime(); volatile LAS unsigned long long* _ps = (volatile LAS unsigned long long*)(F.lds + RING_BYTES + 1024); \
            if (PROBE_MODE == 1) { if ((k) == PROBE_K - 1) _ps[0] = _t1; if ((k) == PROBE_K) _ps[1] = _t1; } else if (PROBE_MODE == 2) { _ps[0] = _ps[0] + (_t1 - _t0); } } } } while (0)
    const float* x_in = args.in[0]; float* xo = args.out;
#define WB(off) wsb(F, (off))
    if (PH_ON(0) && IN(0)) REPS(0) { PHASE_BEGIN(); p0_prologue(F, args); __syncthreads(); }
    if (MK_N_LAUNCHES != 1) SEAM(0);
    for (int l = 0; l < DEPTH; ++l) {
        const int pb = 1 + l * PH_PER_LAYER;
        const size_t wlo = WS_W + (size_t)l * W_LAYER;
        if (PH_ON(1) && IN(pb + 0)) REPS(1) { if (_rep && l) break; PHASE_BEGIN(); if (l == 0) rp1<false, false, false, true>(F, x_in, nullptr, WB(WS_H), nullptr); else rp1<true, true, false, false>(F, nullptr, nullptr, WB(WS_H), nullptr); }
        SEAM(pb + 0);
        if (IN(pb + 1)) {
            if (PH_ON(2)) REPS(2) { PHASE_BEGIN(); PInM p{WB(WS_H), WB(wlo + WO_INM), WB(WS_MIX + MX_Q), WB(WS_MIX + MX_K), WB(WS_MIX + MX_VT), WB(WS_MIX + MX_GR), WB(WS_MIX + MX_GB)}; gm::gemm_phase(F.lds, p, F.G, F.bid, F.tid); }
            if (PH_ON(3)) REPS(3) { PHASE_BEGIN(); PInF p{WB(wlo + WO_F), WB(WS_H), WB(WS_MIX + MX_FT)}; gm::gemm_phase(F.lds, p, F.G, F.bid, F.tid); }
        }
        SEAM(pb + 1);
        if (IN(pb + 2)) {
            int sw = (blockIdx.x >> 3) & 1; asm volatile("" : "+s"(sw));
#pragma unroll 1
            for (int s2 = 0; s2 < 2; ++s2) {
            if (s2 == sw) { if (PH_ON(4)) REPS(4) { PHASE_BEGIN(); attn_phase(F, WB(WS_MIX + MX_Q), WB(WS_MIX + MX_K), WB(WS_MIX + MX_VT), WB(WS_MIX + MX_AH), args.in[1], args.in[4] + l * NH); } }
            else { if (PH_ON(5)) REPS(5) { PHASE_BEGIN(); PF1 p{WB(WS_F1), WB(WS_MIX + MX_FT), WB(WS_MIX + MX_QP), (const float*)(F.ws + WS_TWC), (const float*)(F.ws + WS_TWS)}; gm::gemm_phase(F.lds, p, F.G, F.bid, F.tid); } }
            __syncthreads();
            }
        }
        SEAM(pb + 2);
        if (PH_ON(6) && IN(pb + 3)) REPS(6) { PHASE_BEGIN(); PF2 p{WB(WS_G2), WB(WS_MIX + MX_QP), WB(WS_MIX + MX_AH)}; gm::gemm_phase(F.lds, p, F.G, F.bid, F.tid); }
        SEAM(pb + 3);
        if (PH_ON(7) && IN(pb + 4)) REPS(7) { PHASE_BEGIN(); PMg p{WB(WS_MIX + MX_AH), WB(wlo + WO_MG), WB(WS_MIX + MX_GR), WB(WS_MIX + MX_GB), WB(WS_MIX + MX_MG)}; gm::gemm_phase(F.lds, p, F.G, F.bid, F.tid); }
        SEAM(pb + 4);
        if (PH_ON(8) && IN(pb + 5)) REPS(8) { if (_rep && l) break; PHASE_BEGIN(); POut p{WB(WS_MIX + MX_MG), WB(wlo + WO_OUT), l == 0 ? x_in : (const float*)nullptr, WB(WS_XB)}; gm::gemm_phase(F.lds, p, F.G, F.bid, F.tid); }
        SEAM(pb + 5);
        if (PH_ON(9) && IN(pb + 6)) REPS(9) { PHASE_BEGIN(); if (FFN_FP8) rp2_mfma(F, WB(WS_H), l); else rp2(F, WB(WS_H), l); }
        SEAM(pb + 6);
        if (PH_ON(10) && IN(pb + 7)) REPS(10) { PHASE_BEGIN(); topk_phase(F, args, l); }
        SEAM(pb + 7);
        if (PH_ON(11) && IN(pb + 8)) REPS(11) { PHASE_BEGIN(); PUp p{WB(WS_H), WB(wlo + WO_GU), (const int*)(F.ws + WS_SELTOK), WB(WS_ACT)}; gm::gemm_phase(F.lds, p, F.G, F.bid, F.tid); }
        SEAM(pb + 8);
        if (PH_ON(12) && IN(pb + 9)) REPS(12) { PHASE_BEGIN(); PDn p{WB(WS_ACT), WB(wlo + WO_D), (const float*)(F.ws + WS_SELGATE), WB(WS_Y)}; gm::gemm_phase(F.lds, p, F.G, F.bid, F.tid); }
        SEAM(pb + 9);
    }
    if (PH_ON(13) && IN(N_PHASES - 1)) { PHASE_BEGIN(); rp1<true, false, true, false>(F, nullptr, xo, nullptr, args.in[13]); }
#undef WB
    if (PROBE_MODE) {
        volatile LAS unsigned long long* ps = (volatile LAS unsigned long long*)(F.lds + RING_BYTES + 1024);
        unsigned long long* acc64 = (unsigned long long*)(args.ws + WS_CTL) + 1024;
        if (PROBE_MODE == 2) { if (threadIdx.x == 0) atomicAdd(acc64, ps[0]); XcdBarrier _b; _b.bar = (unsigned*)(args.ws + WS_CTL) + CW_BAR; _b.x = 0; _b.st = F.MISC + 8; xcd_barrier(_b); }
        if (blockIdx.x == 0 && threadIdx.x == 0) {
            unsigned long long d;
            if (PROBE_MODE == 1) { const unsigned long long a = (PROBE_K == 0) ? ps[2] : ps[0]; d = ps[1] - a; }
            else if (PROBE_MODE == 3) { const unsigned long long cyc = ps[5] - ps[3], rt = ps[6] - ps[4]; d = (rt ? (cyc * 100ull / rt) : 0ull) * 100ull / PROBE_AMP; }
            else d = __hip_atomic_load(acc64, __ATOMIC_RELAXED, __HIP_MEMORY_SCOPE_AGENT) / gridDim.x;
            const unsigned long long t0 = __builtin_amdgcn_s_memrealtime();
            while (__builtin_amdgcn_s_memrealtime() - t0 < d * PROBE_AMP) __builtin_amdgcn_s_sleep(16);
        }
    }
#undef IN
#undef SEAM
}

extern "C" void kernel_launch(void* const* d_in, const int* in_sizes, int n_in, void* d_out, int out_size, void* d_ws, size_t ws_size, hipStream_t stream) {
    static int grid = 0;
    if (grid == 0) {
        if (n_in != 14 || out_size != T * D || ws_size < WS_END) { fprintf(stderr, "kernel_launch: unexpected shapes (n_in %d out %d ws %zu); nothing launched\n", n_in, out_size, ws_size); grid = -1; return; }
        int dev = 0, cus = 0, per_cu = 0;
        if (hipGetDevice(&dev) != hipSuccess || hipDeviceGetAttribute(&cus, hipDeviceAttributeMultiprocessorCount, dev) != hipSuccess) { grid = -1; return; }
        if (hipFuncSetAttribute((const void*)mk_fwd, hipFuncAttributeMaxDynamicSharedMemorySize, LDS_BYTES) != hipSuccess) { fprintf(stderr, "kernel_launch: hipFuncSetAttribute failed\n"); grid = -1; return; }
        if (hipOccupancyMaxActiveBlocksPerMultiprocessor(&per_cu, (const void*)mk_fwd, NTHR, LDS_BYTES) != hipSuccess || per_cu < 1) fprintf(stderr, "kernel_launch: occupancy query says %d\n", per_cu);
        (void)hipGetLastError();
        grid = cus;
    }
    if (grid < 0) return;
    (void)hipMemsetAsync((char*)d_ws + WS_CTL, 0, CTL_ZERO_BYTES, stream);
    Args a{};
    for (int i = 0; i < 14; ++i) a.in[i] = (const float*)d_in[i];
    a.out = (float*)d_out; a.ws = (unsigned char*)d_ws;
#if MK_N_LAUNCHES == 1
    a.ph_lo = 0; a.ph_hi = N_PHASES; a.li = 0;
    hipLaunchKernelGGL(mk_fwd, dim3(grid), dim3(NTHR), LDS_BYTES, stream, a);
#else
    for (int ph = 0; ph < N_PHASES; ++ph) { a.ph_lo = ph; a.ph_hi = ph + 1; a.li = ph; hipLaunchKernelGGL(mk_fwd, dim3(grid), dim3(NTHR), LDS_BYTES, stream, a); }
#endif
}
```
